# Optimizing an MI355X kernel written in HIP

```python
import math
import jax, jax.numpy as jnp
from jax import lax
import numpy as np

D_MODEL = 1024
BATCH = 32
SEQ = 256
DEPTH = 4
DEC_BATCH = 8
DEC_SEQ = 4096
PAST_LEN = 256

GRID_W = 64
D_MIX = D_MODEL
D_CONV = D_MIX // 2
D_RET = D_MIX - D_CONV
N_RET_HEADS = 4
HEAD_DK = D_RET // N_RET_HEADS
HEAD_DV = D_RET // N_RET_HEADS
CONV_K = 31
CONV_PAD = (CONV_K - 1) // 2
CHUNK = 128
D_FF = 2816
N_SUB = 3
D_IN = 2 * D_CONV + 4 * D_RET
ALPHA = (2.0 * DEPTH) ** 0.25
BETA = (8.0 * DEPTH) ** -0.25
ROPE_BASE = 10000.0
EPS = 1e-5

kernel_name = 'hybrid_conv_retention_flow_step'


def layer_norm(x, g=None, b=None):
    xf = x.astype(jnp.float32)
    mu = jnp.mean(xf, -1, keepdims=True)
    var = jnp.mean(jnp.square(xf - mu), -1, keepdims=True)
    y = (xf - mu) * lax.rsqrt(var + EPS)
    if g is not None:
        y = y * g.astype(jnp.float32) + b.astype(jnp.float32)
    return y.astype(x.dtype)


def swiglu(h, w1, w2):
    a, b = jnp.split(h @ w1, 2, axis=-1)
    return (jax.nn.silu(a) * b) @ w2


def depthwise_conv(u, w, b):
    y = lax.conv_general_dilated(u, w.astype(u.dtype)[:, None, :], window_strides=(1,),
                                 padding=[(CONV_PAD, CONV_PAD)],
                                 dimension_numbers=('NWC', 'WIO', 'NWC'),
                                 feature_group_count=u.shape[-1])
    return y + b.astype(u.dtype)


def grid_rope_angles(rows):
    t = jnp.arange(rows * GRID_W)
    r = (t // GRID_W).astype(jnp.float32)
    col = (t % GRID_W).astype(jnp.float32)
    nf = HEAD_DK // 4
    inv = ROPE_BASE ** (-jnp.arange(nf, dtype=jnp.float32) / nf)
    return r[:, None] * inv, col[:, None] * inv


def rotate(x, ang):
    x1, x2 = jnp.split(x, 2, axis=-1)
    cos, sin = jnp.cos(ang), jnp.sin(ang)
    return jnp.concatenate([x1 * cos - x2 * sin, x1 * sin + x2 * cos], -1)


def apply_grid_rope(x, rope):
    ang_row, ang_col = rope
    xr, xc = jnp.split(x, 2, axis=-1)
    return jnp.concatenate([rotate(xr, ang_row), rotate(xc, ang_col)], -1)


def retention_chunkwise(q, k, v, log_g, r0):
    b, h, l, dk = q.shape
    dv = v.shape[-1]
    n = l // CHUNK
    qc = q.reshape(b, h, n, CHUNK, dk)
    kc = k.reshape(b, h, n, CHUNK, dk)
    vc = v.reshape(b, h, n, CHUNK, dv)
    idx = jnp.arange(CHUNK, dtype=jnp.float32)
    dist = idx[:, None] - idx[None, :]
    intra_decay = jnp.where(dist >= 0, jnp.exp(log_g[:, None, None] * jnp.maximum(dist, 0.0)), 0.0)
    scores = jnp.einsum('bhncd,bhnsd->bhncs', qc, kc) * intra_decay[None, :, None]
    o_intra = jnp.einsum('bhncs,bhnsv->bhncv', scores, vc)
    k_decay = jnp.exp(log_g[:, None] * (CHUNK - 1.0 - idx))
    q_decay = jnp.exp(log_g[:, None] * (idx + 1.0))
    chunk_kv = jnp.einsum('bhncd,hc,bhncv->nbhdv', kc, k_decay, vc)
    chunk_decay = jnp.exp(log_g * CHUNK)[None, :, None, None]

    def step(r, kv):
        return chunk_decay * r + kv, r

    r_final, r_prev = lax.scan(step, r0, chunk_kv)
    o_inter = jnp.einsum('bhncd,hc,nbhdv->bhncv', qc, q_decay, r_prev)
    return (o_intra + o_inter).reshape(b, h, l, dv), r_final


def mixer(h, w_in, w_out, conv_w, conv_b, conv_ln_g, conv_ln_b, log_gamma, r0_f, r0_b, rope):
    bsz, l, _ = h.shape
    p = h @ w_in
    ca, cg, q, k, v, g = jnp.split(
        p, [D_CONV, 2 * D_CONV, 2 * D_CONV + D_RET, 2 * D_CONV + 2 * D_RET, 2 * D_CONV + 3 * D_RET], axis=-1)
    u = ca * jax.nn.sigmoid(cg)
    if rope is None:
        u = depthwise_conv(u, conv_w, conv_b)
    else:
        rows = l // GRID_W
        u = depthwise_conv(u.reshape(bsz * rows, GRID_W, D_CONV), conv_w, conv_b).reshape(bsz, l, D_CONV)
    u = jax.nn.silu(layer_norm(u, conv_ln_g, conv_ln_b))

    def to_heads(t):
        return t.reshape(bsz, l, N_RET_HEADS, -1).transpose(0, 2, 1, 3).astype(jnp.float32)

    qh, kh, vh = to_heads(q), to_heads(k), to_heads(v)
    if rope is not None:
        qh = apply_grid_rope(qh, rope)
        kh = apply_grid_rope(kh, rope)
    qh = qh * (HEAD_DK ** -0.5)
    o_f, r_f = retention_chunkwise(qh, kh, vh, log_gamma[0], r0_f.astype(jnp.float32))
    o_b, r_b = retention_chunkwise(jnp.flip(qh, 2), jnp.flip(kh, 2), jnp.flip(vh, 2),
                                   log_gamma[1], r0_b.astype(jnp.float32))
    o = layer_norm(o_f + jnp.flip(o_b, 2))
    o = o.transpose(0, 2, 1, 3).reshape(bsz, l, D_RET).astype(h.dtype) * jax.nn.silu(g)
    y = jnp.concatenate([u, o], axis=-1) @ w_out
    return y, r_f, r_b


def layer(x, cond, w_ada, b_ada, ln_g, ln_b, ffn_w1, ffn_w2, w_in, w_out, conv_w, conv_b,
          conv_ln_g, conv_ln_b, log_gamma, r0_f, r0_b, rope):
    mod = (jax.nn.silu(cond) @ w_ada + b_ada)[:, None, :]
    m = jnp.split(mod, 3 * N_SUB, axis=-1)

    def modulate(t, i):
        return t * (1.0 + m[3 * i + 1]) + m[3 * i]

    x = layer_norm(ALPHA * x + 0.5 * m[2] * swiglu(modulate(x, 0), ffn_w1[0], ffn_w2[0]), ln_g[0], ln_b[0])
    y, r_f, r_b = mixer(modulate(x, 1), w_in, w_out, conv_w, conv_b, conv_ln_g, conv_ln_b,
                        log_gamma, r0_f, r0_b, rope)
    x = layer_norm(ALPHA * x + m[5] * y, ln_g[1], ln_b[1])
    x = layer_norm(ALPHA * x + 0.5 * m[8] * swiglu(modulate(x, 2), ffn_w1[1], ffn_w2[1]), ln_g[2], ln_b[2])
    return x, r_f, r_b


def setup_inputs(seed: int = 0) -> dict:
    key = jax.random.key(seed)
    ks = jax.random.split(key, 24)
    nrm = jax.random.normal
    f32 = jnp.float32
    base_logit = jnp.log(2.0 ** (5.0 + jnp.arange(N_RET_HEADS, dtype=f32)) - 1.0)
    return {
        'x_prompt': nrm(ks[0], (BATCH, SEQ, D_MODEL), f32),
        'x_sample': nrm(ks[1], (DEC_BATCH, DEC_SEQ, D_MODEL), f32),
        'state_ret_fwd': nrm(ks[2], (DEC_BATCH, DEPTH, N_RET_HEADS, HEAD_DK, HEAD_DV), f32),
        'state_ret_bwd': nrm(ks[3], (DEC_BATCH, DEPTH, N_RET_HEADS, HEAD_DK, HEAD_DV), f32),
        'c': nrm(ks[4], (DEC_BATCH, D_MODEL), f32),
        'c_ctx': nrm(ks[5], (D_MODEL,), f32),
        'w_ada': nrm(ks[6], (DEPTH, D_MODEL, 3 * N_SUB * D_MODEL), f32) * D_MODEL ** -0.5,
        'b_ada': 0.01 * nrm(ks[7], (DEPTH, 3 * N_SUB * D_MODEL), f32),
        'ln_g': 1.0 + 0.01 * nrm(ks[8], (DEPTH, N_SUB, D_MODEL), f32),
        'ln_b': 0.01 * nrm(ks[9], (DEPTH, N_SUB, D_MODEL), f32),
        'ffn_w1': nrm(ks[10], (DEPTH, 2, D_MODEL, 2 * D_FF), f32) * D_MODEL ** -0.5,
        'ffn_w2': nrm(ks[11], (DEPTH, 2, D_FF, D_MODEL), f32) * (BETA * D_FF ** -0.5),
        'w_in': nrm(ks[12], (DEPTH, D_MODEL, D_IN), f32) * D_MODEL ** -0.5,
        'w_out': nrm(ks[13], (DEPTH, D_MIX, D_MODEL), f32) * (BETA * D_MIX ** -0.5),
        'conv_w': nrm(ks[14], (DEPTH, CONV_K, D_CONV), f32) * CONV_K ** -0.5,
        'conv_b': 0.01 * nrm(ks[15], (DEPTH, D_CONV), f32),
        'conv_ln_g': 1.0 + 0.01 * nrm(ks[16], (DEPTH, D_CONV), f32),
        'conv_ln_b': 0.01 * nrm(ks[17], (DEPTH, D_CONV), f32),
        'ret_decay_logit': base_logit + 0.1 * nrm(ks[18], (DEPTH, 2, N_RET_HEADS), f32),
    }


def reference(x_prompt, x_sample, state_ret_fwd, state_ret_bwd, c, c_ctx, w_ada, b_ada, ln_g, ln_b,
              ffn_w1, ffn_w2, w_in, w_out, conv_w, conv_b, conv_ln_g, conv_ln_b, ret_decay_logit):
    rope = grid_rope_angles(x_sample.shape[1] // GRID_W)
    zero_state = jnp.zeros((x_prompt.shape[0], N_RET_HEADS, HEAD_DK, HEAD_DV), jnp.float32)
    ctx = x_prompt
    lat = x_sample
    ctx_cond = c_ctx[None, :]
    new_fwd = []
    new_bwd = []
    for l in range(DEPTH):
        log_gamma = jax.nn.log_sigmoid(ret_decay_logit[l].astype(jnp.float32))
        ctx, r_f, r_b = layer(ctx, ctx_cond, w_ada[l], b_ada[l], ln_g[l], ln_b[l], ffn_w1[l], ffn_w2[l],
                              w_in[l], w_out[l], conv_w[l], conv_b[l], conv_ln_g[l], conv_ln_b[l],
                              log_gamma, zero_state, zero_state, None)
        new_fwd.append(r_f)
        new_bwd.append(r_b)
        lat, _, _ = layer(lat, c, w_ada[l], b_ada[l], ln_g[l], ln_b[l], ffn_w1[l], ffn_w2[l],
                          w_in[l], w_out[l], conv_w[l], conv_b[l], conv_ln_g[l], conv_ln_b[l],
                          log_gamma, state_ret_fwd[:, l], state_ret_bwd[:, l], rope)
    new_state_ret_fwd = jnp.stack(new_fwd, axis=1)
    new_state_ret_bwd = jnp.stack(new_bwd, axis=1)
    return (ctx, lat, new_state_ret_fwd, new_state_ret_bwd)
```

```cpp
#include <hip/hip_runtime.h>
#include <hip/hip_cooperative_groups.h>
#include <cstdio>
namespace cg = cooperative_groups;

#ifndef MK_PER_PHASE
#define MK_PER_PHASE 0
#endif

namespace pg8 {
#define PG8_LAS __attribute__((address_space(3)))
typedef unsigned short bf16_t;
typedef short bf16x8 __attribute__((ext_vector_type(8)));
typedef float f32x4 __attribute__((ext_vector_type(4)));
typedef unsigned u32x4 __attribute__((ext_vector_type(4)));
constexpr int BM = 256, BK = 64, HALF = 128, HTB = HALF * BK * 2, STAGE_BYTES = 8 * HTB, NXCD = 8, WGM = 8;
__host__ __device__ __forceinline__ int lds_byte(int r, int c) { const int st = (r >> 4) * 2 + (c >> 5), rr = r & 15, cc = c & 31, ob = rr * 64 + cc * 2; return st * 1024 + (ob ^ (((ob >> 9) & 1) << 5)); }
__host__ __device__ __forceinline__ void stage_rc(int b, int& R, int& C) { const int st = b / 1024, sb = b % 1024, swz = sb ^ (((sb >> 9) & 1) << 5); R = (st >> 1) * 16 + swz / 64; C = (st & 1) * 32 + (swz % 64) / 2; }
__host__ __device__ __forceinline__ int perm32(int rho) { const int n = rho >> 4, i = rho & 15; return 8 * (i >> 2) + 4 * n + (i & 3); }
struct Unit { int pm, pn; };
struct Gemm { const bf16_t* A; const bf16_t* Bt; int M, N, K; };
struct StaticOrder {
    int nM, nN, nwg, G, c;
    __host__ __device__ void init(int M, int N, int G_, int c_) { nM = M / BM; nN = N / BM; nwg = nM * nN; G = G_; c = c_; }
    __host__ __device__ bool next(int i, Unit& u) const {
        const long L = (long)i * G + c; if (L >= nwg) return false;
        int wgid = (int)L; { const int q = nwg / NXCD, r = nwg % NXCD, xcd = wgid % NXCD, off = wgid / NXCD; wgid = (xcd < r ? xcd * (q + 1) : r * (q + 1) + (xcd - r) * q) + off; }
        const int nig = WGM * nN, gid = wgid / nig, fm = gid * WGM, gsz = (nM - fm) < WGM ? (nM - fm) : WGM;
        u.pm = fm + ((wgid % nig) % gsz); u.pn = (wgid % nig) / gsz; return true;
    }
    __device__ __forceinline__ void a_ready(const Unit&) const {}
    __device__ __forceinline__ void done(const Unit&) const {}
};
template <class Epi, class Sched>
__device__ __forceinline__ void gemm_phase(PG8_LAS unsigned char* lds, const Gemm g, const Sched& S, const Epi& E) {
    int tid_ = threadIdx.x; asm volatile("" : "+v"(tid_)); const int tid = tid_, wid = __builtin_amdgcn_readfirstlane(tid >> 6), lane = tid & 63, wr = wid >> 2, wc = wid & 3, fr = lane & 15, fq = lane >> 4;
    const int K = g.K, nt = K / BK;
    unsigned voffA[2], voffB[2];
#pragma unroll
    for (int i = 0; i < 2; ++i) { int R, C; stage_rc(tid * 16 + i * 8192, R, C); const int Rb = Epi::PERM ? ((R & ~31) + perm32(R & 31)) : R;
        voffA[i] = (unsigned)(R * K + C) * 2u; voffB[i] = (unsigned)(Rb * K + C) * 2u; }
    const size_t kstep = (size_t)(BK * 2);
    const size_t hstep = (size_t)HALF * K * 2;
    const size_t tstep = 2 * hstep;
    const unsigned ldsw = (unsigned)wid * 1024u;
    const int aoff = lds_byte(wr * 64 + fr, fq * 8), boff = lds_byte(wc * 32 + fr, fq * 8);
#define PG8_SA(b, h) (((b) * 2 + (h)) * HTB)
#define PG8_SB(b, h) ((4 + (b) * 2 + (h)) * HTB)
#define PG8_STAGE(bufoff, gbase, voff) do { _Pragma("unroll") for (int _i = 0; _i < 2; ++_i) \
        __builtin_amdgcn_global_load_lds((const unsigned*)((const char*)(gbase) + (voff)[_i]), (PG8_LAS unsigned*)(lds + (bufoff) + ldsw + _i * 8192), 16, 0, 0); } while (0)
#define PG8_LDA(dst, b, h) do { _Pragma("unroll") for (int m = 0; m < 4; ++m) _Pragma("unroll") for (int k = 0; k < 2; ++k) dst[m][k] = *(const PG8_LAS bf16x8*)(lds + PG8_SA(b, h) + aoff + m * 2048 + k * 1024); } while (0)
#define PG8_LDB(dst, b, h) do { _Pragma("unroll") for (int n = 0; n < 2; ++n) _Pragma("unroll") for (int k = 0; k < 2; ++k) dst[n][k] = *(const PG8_LAS bf16x8*)(lds + PG8_SB(b, h) + boff + n * 2048 + k * 1024); } while (0)
#define PG8_MMA(ai, bj, At, Bt) do { __builtin_amdgcn_s_setprio(1); _Pragma("unroll") for (int m = 0; m < 4; ++m) _Pragma("unroll") for (int n = 0; n < 2; ++n) _Pragma("unroll") for (int k = 0; k < 2; ++k) \
        acc[ai][bj][m][n] = __builtin_amdgcn_mfma_f32_16x16x32_bf16(Bt[n][k], At[m][k], acc[ai][bj][m][n], 0, 0, 0); __builtin_amdgcn_s_setprio(0); } while (0)
#define PG8_WAIT_V(n) asm volatile("s_waitcnt vmcnt(" #n ")" ::: "memory")
#define PG8_WAIT_L(n) asm volatile("s_waitcnt lgkmcnt(" #n ")" ::: "memory")
#define PG8_BAR __builtin_amdgcn_s_barrier()
#define PG8_SCHED __builtin_amdgcn_sched_barrier(0)
    Unit cur, nxt; int ui = 0;
    if (!S.next(0, cur)) return;
    f32x4 acc[2][2][4][2];
#pragma unroll
    for (int a = 0; a < 2; ++a)
#pragma unroll
        for (int b = 0; b < 2; ++b)
#pragma unroll
            for (int m = 0; m < 4; ++m)
#pragma unroll
                for (int n = 0; n < 2; ++n) acc[a][b][m][n] = (f32x4){0.f, 0.f, 0.f, 0.f};
    bf16x8 At[4][2], B0[2][2], B1[2][2];
    const char* cA = (const char*)g.A + (size_t)cur.pm * tstep; const char* cB = (const char*)g.Bt + (size_t)cur.pn * tstep;
    S.a_ready(cur);
    PG8_STAGE(PG8_SB(0, 0), cB, voffB); PG8_STAGE(PG8_SA(0, 0), cA, voffA); PG8_STAGE(PG8_SB(0, 1), cB + hstep, voffB); PG8_STAGE(PG8_SA(0, 1), cA + hstep, voffA);
    if (wr == 1) PG8_BAR;
    PG8_WAIT_V(4); PG8_BAR;
    PG8_STAGE(PG8_SB(1, 0), cB + kstep, voffB); PG8_STAGE(PG8_SA(1, 0), cA + kstep, voffA); PG8_STAGE(PG8_SB(1, 1), cB + hstep + kstep, voffB);
    PG8_WAIT_V(6); PG8_BAR;
    for (;;) {
        const bool has_next = S.next(ui + 1, nxt);
        const char* nA = has_next ? (const char*)g.A + (size_t)nxt.pm * tstep : cA; const char* nB = has_next ? (const char*)g.Bt + (size_t)nxt.pn * tstep : cB;
        for (int t = 0; t < nt; t += 2) {
            const bool last = (t == nt - 2);
            const char* a1 = cA + (size_t)(t + 1) * kstep;
            const char* a2 = last ? nA : cA + (size_t)(t + 2) * kstep; const char* b2 = last ? nB : cB + (size_t)(t + 2) * kstep;
            const char* a3 = a2 + kstep; const char* b3 = b2 + kstep;
            if (last && has_next) S.a_ready(nxt);
            PG8_LDB(B0, 0, 0); PG8_SCHED; PG8_LDA(At, 0, 0); PG8_STAGE(PG8_SA(1, 1), a1 + hstep, voffA);
            PG8_WAIT_L(8); PG8_BAR; PG8_WAIT_L(0); PG8_MMA(0, 0, At, B0); PG8_BAR; PG8_SCHED;
            PG8_LDB(B1, 0, 1); PG8_STAGE(PG8_SB(0, 0), b2, voffB);
            PG8_BAR; PG8_WAIT_L(0); PG8_MMA(0, 1, At, B1); PG8_BAR;
            PG8_LDA(At, 0, 1); PG8_STAGE(PG8_SA(0, 0), a2, voffA);
            PG8_BAR; PG8_WAIT_L(0); PG8_MMA(1, 0, At, B0); PG8_BAR; PG8_SCHED;
            PG8_STAGE(PG8_SB(0, 1), b2 + hstep, voffB);
            PG8_WAIT_V(6); PG8_BAR; PG8_MMA(1, 1, At, B1); PG8_BAR;
            PG8_LDB(B0, 1, 0); PG8_SCHED; PG8_LDA(At, 1, 0); PG8_STAGE(PG8_SA(0, 1), a2 + hstep, voffA);
            PG8_WAIT_L(8); PG8_BAR; PG8_WAIT_L(0); PG8_MMA(0, 0, At, B0); PG8_BAR; PG8_SCHED;
            PG8_LDB(B1, 1, 1); PG8_STAGE(PG8_SB(1, 0), b3, voffB);
            PG8_BAR; PG8_WAIT_L(0); PG8_MMA(0, 1, At, B1); PG8_BAR;
            PG8_LDA(At, 1, 1); PG8_STAGE(PG8_SA(1, 0), a3, voffA);
            PG8_BAR; PG8_WAIT_L(0); PG8_MMA(1, 0, At, B0); PG8_BAR; PG8_SCHED;
            PG8_STAGE(PG8_SB(1, 1), b3 + hstep, voffB);
            PG8_WAIT_V(6); PG8_BAR; PG8_MMA(1, 1, At, B1); PG8_BAR;
        }
        if constexpr (!Epi::AFTER_DRAIN) { E(acc, cur, wr, wc, fr, fq); S.done(cur); }
        if (!has_next) break;
#pragma unroll
        for (int a = 0; a < 2; ++a)
#pragma unroll
            for (int b = 0; b < 2; ++b)
#pragma unroll
                for (int m = 0; m < 4; ++m)
#pragma unroll
                    for (int n = 0; n < 2; ++n) acc[a][b][m][n] = (f32x4){0.f, 0.f, 0.f, 0.f};
        cur = nxt; cA = nA; cB = nB; ++ui;
    }
    PG8_WAIT_V(0);
    if (wr == 0) PG8_BAR;
    PG8_BAR;
    if constexpr (Epi::AFTER_DRAIN) { E.fused(acc, cur, wr, wc, fr, fq, lds, wid, lane); S.done(cur); }
#undef PG8_SA
#undef PG8_SB
#undef PG8_STAGE
#undef PG8_LDA
#undef PG8_LDB
#undef PG8_MMA
#undef PG8_WAIT_V
#undef PG8_WAIT_L
#undef PG8_BAR
#undef PG8_SCHED
}
}

#define LAS __attribute__((address_space(3)))
using pg8::bf16_t; using pg8::bf16x8; using pg8::f32x4;
typedef float f32x2 __attribute__((ext_vector_type(2)));
typedef unsigned u32x2 __attribute__((ext_vector_type(2)));
typedef unsigned u32x4v __attribute__((ext_vector_type(4)));

constexpr int D = 1024, DFF = 2816, DIN = 3072, DEPTH = 4;
constexpr int T_CTX = 8192, T_LAT = 32768, T = T_CTX + T_LAT;
constexpr int NCHUNK = T / 128;
constexpr int MODW = 9 * D;
constexpr float ALPHA_F = 1.6817928305074290f;
constexpr float EPS_F = 1e-5f;
constexpr int LDS_WORK = 139264;
constexpr int LDS_BYTES = LDS_WORK + 16;

constexpr size_t WS_X = 0;
constexpr size_t WS_H = WS_X + (size_t)T * D * 2;
constexpr size_t WS_MIX = WS_H + (size_t)T * D * 2;
constexpr size_t WS_U = WS_MIX + (size_t)T * D * 2;
constexpr size_t SZ_T512 = (size_t)T * 512 * 2;
constexpr size_t WS_RPT = WS_U + 6 * SZ_T512;
constexpr size_t WS_WT = WS_RPT + (size_t)2 * NCHUNK * 4 * 16384 * 2;
constexpr size_t WT_W1 = 0, WT_W2 = WT_W1 + (size_t)2 * 5632 * 1024, WT_WIN = WT_W2 + (size_t)2 * 1024 * 2816, WT_WOUT = WT_WIN + (size_t)3072 * 1024, WT_ELEMS = WT_WOUT + (size_t)1024 * 1024;
constexpr size_t WS_MOD = WS_WT + WT_ELEMS * 2;
constexpr size_t WS_ROPE = WS_MOD + (size_t)DEPTH * 9 * MODW * 4;
constexpr size_t WS_SLOT = WS_ROPE + 64 * 32 * 2 * 4;
constexpr size_t WS_CNT = WS_SLOT + (size_t)T * 16 * 8;
constexpr int N_CNT = 12 * 160 * 2;
constexpr size_t WS_BAR = WS_CNT + (size_t)N_CNT * 4;
constexpr size_t WS_END = WS_BAR + 3456 * 4;

constexpr size_t OUT_YS = 0, OUT_SF = (size_t)T * D, OUT_SB = OUT_SF + (size_t)32 * DEPTH * 4 * 16384;

struct Params {
    const float* in[19];
    float* out;
    unsigned char* ws;
    int ph_lo, ph_hi;
};
typedef const __attribute__((address_space(4))) Params* CP;
enum { I_XP = 0, I_XS, I_SF, I_SB, I_C, I_CCTX, I_WADA, I_BADA, I_LNG, I_LNB, I_W1, I_W2, I_WIN, I_WOUT, I_CW, I_CB, I_CLG, I_CLB, I_DEC };

__device__ __forceinline__ unsigned cvt_pk_bf16(float lo, float hi) { unsigned r; asm("v_cvt_pk_bf16_f32 %0, %1, %2" : "=v"(r) : "v"(lo), "v"(hi)); return r; }
__device__ __forceinline__ int my_tid() { int t = threadIdx.x; asm volatile("" : "+v"(t)); return t; }
__device__ __forceinline__ float bf_lo(unsigned u) { return __uint_as_float(u << 16); }
__device__ __forceinline__ float bf_hi(unsigned u) { return __uint_as_float(u & 0xffff0000u); }
__device__ __forceinline__ float fast_sigmoid(float x) { return __builtin_amdgcn_rcpf(1.0f + __expf(-x)); }
__device__ __forceinline__ float fast_silu(float x) { return x * fast_sigmoid(x); }
__device__ __forceinline__ int mod_row_of_tile(int pm) { return pm < 32 ? 0 : 1 + ((pm - 32) >> 4); }
__device__ __forceinline__ int mod_row_of_tok(int t) { return t < T_CTX ? 0 : 1 + ((t - T_CTX) >> 12); }
__device__ __forceinline__ float wave_sum(float v) {
#pragma unroll
    for (int o = 32; o >= 1; o >>= 1) v += __shfl_xor(v, o, 64);
    return v;
}
__device__ __forceinline__ float log_sigmoid_f(float x) { return -log1pf(__expf(-x)); }

struct EpiSwiglu {
    static constexpr bool PERM = true, AFTER_DRAIN = false;
    bf16_t* O;
    __device__ __forceinline__ void operator()(const f32x4 (&acc)[2][2][4][2], const pg8::Unit& u, int wr, int wc, int fr, int fq) const {
        const int row0 = u.pm * 256 + wr * 64 + fr, col0 = u.pn * 128 + wc * 32 + 8 * fq;
#pragma unroll
        for (int ai = 0; ai < 2; ++ai)
#pragma unroll
            for (int m = 0; m < 4; ++m) {
                bf16_t* dst = O + (size_t)(row0 + ai * 128 + m * 16) * DFF + col0;
                const f32x4 a0 = acc[ai][0][m][0], a1 = acc[ai][0][m][1], b0 = acc[ai][1][m][0], b1 = acc[ai][1][m][1];
                u32x4v o;
                o[0] = cvt_pk_bf16(fast_silu(a0[0]) * b0[0], fast_silu(a0[1]) * b0[1]);
                o[1] = cvt_pk_bf16(fast_silu(a0[2]) * b0[2], fast_silu(a0[3]) * b0[3]);
                o[2] = cvt_pk_bf16(fast_silu(a1[0]) * b1[0], fast_silu(a1[1]) * b1[1]);
                o[3] = cvt_pk_bf16(fast_silu(a1[2]) * b1[2], fast_silu(a1[3]) * b1[3]);
                *(u32x4v*)dst = o;
            }
    }
};
struct EpiResid {
    static constexpr bool PERM = false, AFTER_DRAIN = false;
    float* X; const float* gate; float gscale;
    __device__ __forceinline__ void operator()(const f32x4 (&acc)[2][2][4][2], const pg8::Unit& u, int wr, int wc, int fr, int fq) const {
        const int row0 = u.pm * 256 + wr * 64 + fr, col0 = u.pn * 256 + wc * 32 + 4 * fq;
        const float* gp = gate + (size_t)mod_row_of_tile(u.pm) * MODW + col0;
#pragma unroll
        for (int ai = 0; ai < 2; ++ai)
#pragma unroll
            for (int m = 0; m < 4; ++m) {
                float* rowp = X + (size_t)(row0 + ai * 128 + m * 16) * D + col0;
#pragma unroll
                for (int bj = 0; bj < 2; ++bj)
#pragma unroll
                    for (int n = 0; n < 2; ++n) {
                        const f32x4 gv = *(const f32x4*)(gp + bj * 128 + n * 16) * gscale;
                        f32x4 x = *(const f32x4*)(rowp + bj * 128 + n * 16);
                        x = x * ALPHA_F + gv * acc[ai][bj][m][n];
                        *(f32x4*)(rowp + bj * 128 + n * 16) = x;
                    }
            }
    }
};
struct QuadOrder {
    int nM, c;
    __device__ void init(int M, int c_) { nM = M / 256; c = c_; }
    __device__ bool next(int i, pg8::Unit& u) const {
        const int xcd = c & 7, k = c >> 3, full = nM >> 6;
        if (i < full) { u.pm = 64 * i + 8 * xcd + (k >> 2); u.pn = k & 3; return true; }
        if (i == full) { const int per = (nM - 64 * full) >> 3; if ((k >> 2) < per) { u.pm = 64 * full + per * xcd + (k >> 2); u.pn = k & 3; return true; } }
        return false;
    }
    __device__ __forceinline__ void a_ready(const pg8::Unit&) const {}
    __device__ __forceinline__ void done(const pg8::Unit&) const {}
};
typedef _Float16 f16x8 __attribute__((ext_vector_type(8)));
typedef float f32x8 __attribute__((ext_vector_type(8)));
struct EpiResLn {
    static constexpr bool PERM = true, AFTER_DRAIN = false;
    CP p; int l, sub;
    __device__ __forceinline__ void operator()(f32x4 (&acc)[2][2][4][2], const pg8::Unit& u, int wr, int wc, int fr, int fq) const {
        CP pp = p; asm volatile("" : "+s"(pp));
        f16x8* XP = (f16x8*)(pp->ws + WS_X); bf16_t* H = (bf16_t*)(pp->ws + WS_H);
        const bool fin = (l == DEPTH - 1 && sub == 2);
        float* OUT = pp->out;
        const float* MOD = (const float*)(pp->ws + WS_MOD);
        const float* gate = MOD + (size_t)l * 9 * MODW + (size_t)(sub == 1 ? 5 : (sub == 0 ? 2 : 8)) * D;
        const float gscale = sub == 1 ? 1.0f : 0.5f;
        const float* lng = pp->in[I_LNG] + (size_t)(l * 3 + sub) * D; const float* lnb = pp->in[I_LNB] + (size_t)(l * 3 + sub) * D;
        const int nl = sub == 2 ? (l + 1 < DEPTH ? l + 1 : l) : l, ns = sub == 2 ? 0 : sub + 1;
        const float* modn = MOD + (size_t)nl * 9 * MODW + (size_t)(3 * ns) * D;
        char* slots = (char*)(pp->ws + WS_SLOT); unsigned* cnt = (unsigned*)(pp->ws + WS_CNT) + (size_t)(l * 3 + sub) * 320;
        const int lane = fr + 16 * fq;
        const int row0 = u.pm * 256 + wr * 64 + fr, col0 = u.pn * 256 + wc * 32 + 8 * fq;
        const unsigned xp0 = (unsigned)((((u.pm * 4 + u.pn) * 8 + wr * 4 + wc) * 16) * 64 + lane);
        const int mrow = mod_row_of_tile(u.pm);
        const float* gp = gate + (size_t)mrow * MODW + col0;
        float s1[8], s2[8];
#pragma unroll
        for (int i = 0; i < 8; ++i) { s1[i] = 0.f; s2[i] = 0.f; }
        f16x8 xq[16];
#pragma unroll
        for (int gq = 0; gq < 16; ++gq) xq[gq] = XP[xp0 + (unsigned)(gq * 64)];
        __builtin_amdgcn_sched_barrier(0);
#pragma unroll
        for (int bj = 0; bj < 2; ++bj) {
            const f32x4 gv0 = *(const f32x4*)(gp + bj * 128) * gscale, gv1 = *(const f32x4*)(gp + bj * 128 + 4) * gscale;
#pragma unroll
            for (int ai = 0; ai < 2; ++ai)
#pragma unroll
                for (int m = 0; m < 4; ++m) {
                    const f32x8 x = __builtin_convertvector(xq[(ai * 2 + bj) * 4 + m], f32x8);
                    const f32x4 z0 = (f32x4){x[0], x[1], x[2], x[3]} * ALPHA_F + gv0 * acc[ai][bj][m][0];
                    const f32x4 z1 = (f32x4){x[4], x[5], x[6], x[7]} * ALPHA_F + gv1 * acc[ai][bj][m][1];
                    acc[ai][bj][m][0] = z0; acc[ai][bj][m][1] = z1;
                    s1[ai * 4 + m] += ((z0[0] + z0[1]) + (z0[2] + z0[3])) + ((z1[0] + z1[1]) + (z1[2] + z1[3]));
                    s2[ai * 4 + m] += ((z0[0] * z0[0] + z0[1] * z0[1]) + (z0[2] * z0[2] + z0[3] * z0[3])) + ((z1[0] * z1[0] + z1[1] * z1[1]) + (z1[2] * z1[2] + z1[3] * z1[3]));
                }
        }
#pragma unroll
        for (int i = 0; i < 8; ++i) { s1[i] += __shfl_xor(s1[i], 16, 64); s2[i] += __shfl_xor(s2[i], 16, 64); }
#pragma unroll
        for (int i = 0; i < 8; ++i) { s1[i] += __shfl_xor(s1[i], 32, 64); s2[i] += __shfl_xor(s2[i], 32, 64); }
        const unsigned so0 = (unsigned)(row0 * 64);
#pragma unroll
        for (int i = 0; i < 8; ++i) {
            if ((i >> 1) == fq) {
                const unsigned v = (unsigned)__builtin_bit_cast(unsigned short, (_Float16)s1[i]) | ((unsigned)__builtin_bit_cast(unsigned short, (_Float16)s2[i]) << 16);
                __hip_atomic_store((unsigned*)(slots + (so0 + (unsigned)(((i >> 2) * 128 + (i & 3) * 16) * 64) + (unsigned)((u.pn * 4 + wc) * 4))), v, __ATOMIC_RELAXED, __HIP_MEMORY_SCOPE_AGENT);
            }
        }
        asm volatile("s_waitcnt vmcnt(0)" ::: "memory");
        const float* mp = modn + (size_t)mrow * MODW + col0;
        const f32x4 pg0 = *(const f32x4*)(lng + col0), pg1 = *(const f32x4*)(lng + col0 + 4), pb0 = *(const f32x4*)(lnb + col0), pb1 = *(const f32x4*)(lnb + col0 + 4);
        unsigned* cp = cnt + (u.pm * 2 + wr);
        if (lane == 0) __hip_atomic_fetch_add(cp, 1u, __ATOMIC_RELAXED, __HIP_MEMORY_SCOPE_AGENT);
        for (int spins = 0; spins < (1 << 20); ++spins) {
            const unsigned v = __builtin_amdgcn_readfirstlane(__hip_atomic_load(cp, __ATOMIC_RELAXED, __HIP_MEMORY_SCOPE_AGENT));
            if (v >= 16u) break;
            __builtin_amdgcn_s_sleep(4);
        }
        unsigned xp1 = xp0, so1 = so0; asm volatile("" : "+v"(xp1), "+v"(so1));
        float mu[8], rs[8];
        const __amdgpu_buffer_rsrc_t srs = __builtin_amdgcn_make_buffer_rsrc((void*)slots, (short)0, (int)(T * 64), 0x00020000);
        {
            u32x4v sv[8];
#pragma unroll
            for (int i = 0; i < 8; ++i) sv[i] = __builtin_amdgcn_raw_buffer_load_b128(srs, so1 + (unsigned)(((i >> 2) * 128 + (i & 3) * 16) * 64) + (unsigned)(16 * fq), 0, 16);
            __builtin_amdgcn_sched_barrier(0);
            float sa[8], sb[8];
#pragma unroll
            for (int i = 0; i < 8; ++i) {
                float a = 0.f, b = 0.f;
#pragma unroll
                for (int q = 0; q < 4; ++q) { a += (float)__builtin_bit_cast(_Float16, (unsigned short)(sv[i][q] & 0xffffu)); b += (float)__builtin_bit_cast(_Float16, (unsigned short)(sv[i][q] >> 16)); }
                sa[i] = a; sb[i] = b;
            }
#pragma unroll
            for (int i = 0; i < 8; ++i) { sa[i] += __shfl_xor(sa[i], 16, 64); sb[i] += __shfl_xor(sb[i], 16, 64); }
#pragma unroll
            for (int i = 0; i < 8; ++i) { sa[i] += __shfl_xor(sa[i], 32, 64); sb[i] += __shfl_xor(sb[i], 32, 64); }
#pragma unroll
            for (int i = 0; i < 8; ++i) {
                const float m_ = sa[i] * (1.0f / D);
                mu[i] = m_; rs[i] = rsqrtf(fmaxf(sb[i] * (1.0f / D) - m_ * m_, 0.f) + EPS_F);
            }
        }
        const unsigned ro0 = (unsigned)(row0 * D + col0);
#pragma unroll
        for (int bj = 0; bj < 2; ++bj) {
            const int co = bj * 128;
            const f32x4 g0 = bj ? *(const f32x4*)(lng + col0 + co) : pg0, g1 = bj ? *(const f32x4*)(lng + col0 + co + 4) : pg1, b0 = bj ? *(const f32x4*)(lnb + col0 + co) : pb0, b1 = bj ? *(const f32x4*)(lnb + col0 + co + 4) : pb1;
            const f32x4 sh0 = *(const f32x4*)(mp + co), sh1 = *(const f32x4*)(mp + co + 4), sc0 = *(const f32x4*)(mp + D + co) + 1.0f, sc1 = *(const f32x4*)(mp + D + co + 4) + 1.0f;
#pragma unroll
            for (int ai = 0; ai < 2; ++ai)
#pragma unroll
                for (int m = 0; m < 4; ++m) {
                    const f32x4 x0 = (acc[ai][bj][m][0] - mu[ai * 4 + m]) * rs[ai * 4 + m] * g0 + b0, x1 = (acc[ai][bj][m][1] - mu[ai * 4 + m]) * rs[ai * 4 + m] * g1 + b1;
                    const unsigned ro = ro0 + (unsigned)((ai * 128 + m * 16) * D + co);
                    if (fin) { *(f32x4*)(OUT + ro) = x0; *(f32x4*)(OUT + ro + 4) = x1; }
                    else {
                        const f32x8 xv = (f32x8){x0[0], x0[1], x0[2], x0[3], x1[0], x1[1], x1[2], x1[3]};
                        XP[xp1 + (unsigned)(((ai * 2 + bj) * 4 + m) * 64)] = __builtin_convertvector(xv, f16x8);
                        const f32x4 h0 = x0 * sc0 + sh0, h1 = x1 * sc1 + sh1;
                        u32x4v o; o[0] = cvt_pk_bf16(h0[0], h0[1]); o[1] = cvt_pk_bf16(h0[2], h0[3]); o[2] = cvt_pk_bf16(h1[0], h1[1]); o[3] = cvt_pk_bf16(h1[2], h1[3]);
                        *(u32x4v*)(H + ro) = o;
                    }
                }
            __builtin_amdgcn_sched_barrier(0);
        }
    }
};
struct EpiMixIn {
    static constexpr bool PERM = true, AFTER_DRAIN = false;
    bf16_t *UPRE, *Q, *K, *KT, *VT, *SG; const float* rope;
    __device__ __forceinline__ void operator()(const f32x4 (&acc)[2][2][4][2], const pg8::Unit& u, int wr, int wc, int fr, int fq) const {
        const int row0 = u.pm * 256 + wr * 64 + fr;
        const int pn = u.pn;
        if (pn < 4) {
            const int col0 = pn * 128 + wc * 32 + 8 * fq;
#pragma unroll
            for (int ai = 0; ai < 2; ++ai)
#pragma unroll
                for (int m = 0; m < 4; ++m) {
                    const f32x4 a0 = acc[ai][0][m][0], a1 = acc[ai][0][m][1], b0 = acc[ai][1][m][0], b1 = acc[ai][1][m][1];
                    u32x4v o;
                    o[0] = cvt_pk_bf16(a0[0] * fast_sigmoid(b0[0]), a0[1] * fast_sigmoid(b0[1]));
                    o[1] = cvt_pk_bf16(a0[2] * fast_sigmoid(b0[2]), a0[3] * fast_sigmoid(b0[3]));
                    o[2] = cvt_pk_bf16(a1[0] * fast_sigmoid(b1[0]), a1[1] * fast_sigmoid(b1[1]));
                    o[3] = cvt_pk_bf16(a1[2] * fast_sigmoid(b1[2]), a1[3] * fast_sigmoid(b1[3]));
                    *(u32x4v*)(UPRE + (size_t)(row0 + ai * 128 + m * 16) * 512 + col0) = o;
                }
        } else if (pn < 8) {
            const bool isk = pn >= 6, lat = u.pm >= 32;
            const int head = 2 * (pn & 1) + (wc >> 1), colrot = wc & 1, dbase = 64 * colrot + 8 * fq;
            const float sc = isk ? 1.0f : 0.08838834764831845f;
            bf16_t* RM = isk ? K : Q;
#pragma unroll
            for (int ai = 0; ai < 2; ++ai)
#pragma unroll
                for (int m = 0; m < 4; ++m) {
                    const int row = row0 + ai * 128 + m * 16;
                    const int sp = (row - T_CTX) & 4095, pos = colrot ? (sp & 63) : (sp >> 6);
                    const float* rp = rope + (size_t)(pos * 32 + 8 * fq) * 2;
                    bf16_t* dst = RM + (size_t)row * 512 + head * 128 + dbase;
                    const int chunk = row >> 7, c = row & 127;
                    bf16_t* kt = KT + ((size_t)(chunk * 4 + head) * 128 + dbase) * 128 + c;
#pragma unroll
                    for (int n = 0; n < 2; ++n) {
                        const f32x4 x1 = acc[ai][0][m][n], x2 = acc[ai][1][m][n];
                        f32x4 o1, o2;
                        if (lat) {
                            const f32x4 csa = *(const f32x4*)(rp + 8 * n), csb = *(const f32x4*)(rp + 8 * n + 4);
                            o1[0] = x1[0] * csa[0] - x2[0] * csa[1]; o2[0] = x1[0] * csa[1] + x2[0] * csa[0];
                            o1[1] = x1[1] * csa[2] - x2[1] * csa[3]; o2[1] = x1[1] * csa[3] + x2[1] * csa[2];
                            o1[2] = x1[2] * csb[0] - x2[2] * csb[1]; o2[2] = x1[2] * csb[1] + x2[2] * csb[0];
                            o1[3] = x1[3] * csb[2] - x2[3] * csb[3]; o2[3] = x1[3] * csb[3] + x2[3] * csb[2];
                        } else { o1 = x1; o2 = x2; }
                        o1 *= sc; o2 *= sc;
                        u32x2 p1, p2;
                        p1[0] = cvt_pk_bf16(o1[0], o1[1]); p1[1] = cvt_pk_bf16(o1[2], o1[3]);
                        p2[0] = cvt_pk_bf16(o2[0], o2[1]); p2[1] = cvt_pk_bf16(o2[2], o2[3]);
                        *(u32x2*)(dst + 4 * n) = p1; *(u32x2*)(dst + 32 + 4 * n) = p2;
                        if (isk) {
#pragma unroll
                            for (int q = 0; q < 2; ++q) {
                                kt[(size_t)(4 * n + 2 * q) * 128] = (bf16_t)(p1[q] & 0xffffu); kt[(size_t)(4 * n + 2 * q + 1) * 128] = (bf16_t)(p1[q] >> 16);
                                kt[(size_t)(4 * n + 2 * q + 32) * 128] = (bf16_t)(p2[q] & 0xffffu); kt[(size_t)(4 * n + 2 * q + 33) * 128] = (bf16_t)(p2[q] >> 16);
                            }
                        }
                    }
                }
        } else if (pn < 10) {
#pragma unroll
            for (int ai = 0; ai < 2; ++ai)
#pragma unroll
                for (int m = 0; m < 4; ++m) {
                    const int row = row0 + ai * 128 + m * 16, chunk = row >> 7, c = row & 127;
#pragma unroll
                    for (int bj = 0; bj < 2; ++bj) {
                        const int head = 2 * (pn - 8) + bj, d0 = wc * 32 + 8 * fq;
                        bf16_t* vt = VT + ((size_t)(chunk * 4 + head) * 128 + d0) * 128 + c;
#pragma unroll
                        for (int n = 0; n < 2; ++n) {
                            const unsigned pa = cvt_pk_bf16(acc[ai][bj][m][n][0], acc[ai][bj][m][n][1]), pb = cvt_pk_bf16(acc[ai][bj][m][n][2], acc[ai][bj][m][n][3]);
                            vt[(size_t)(4 * n + 0) * 128] = (bf16_t)(pa & 0xffffu); vt[(size_t)(4 * n + 1) * 128] = (bf16_t)(pa >> 16);
                            vt[(size_t)(4 * n + 2) * 128] = (bf16_t)(pb & 0xffffu); vt[(size_t)(4 * n + 3) * 128] = (bf16_t)(pb >> 16);
                        }
                    }
                }
        } else {
            const int col0 = (pn - 10) * 256 + wc * 32 + 8 * fq;
#pragma unroll
            for (int ai = 0; ai < 2; ++ai)
#pragma unroll
                for (int m = 0; m < 4; ++m)
#pragma unroll
                    for (int bj = 0; bj < 2; ++bj) {
                        const f32x4 a0 = acc[ai][bj][m][0], a1 = acc[ai][bj][m][1];
                        u32x4v o;
                        o[0] = cvt_pk_bf16(fast_silu(a0[0]), fast_silu(a0[1])); o[1] = cvt_pk_bf16(fast_silu(a0[2]), fast_silu(a0[3]));
                        o[2] = cvt_pk_bf16(fast_silu(a1[0]), fast_silu(a1[1])); o[3] = cvt_pk_bf16(fast_silu(a1[2]), fast_silu(a1[3]));
                        *(u32x4v*)(SG + (size_t)(row0 + ai * 128 + m * 16) * 512 + col0 + bj * 128) = o;
                    }
        }
    }
};

__device__ __forceinline__ int wt_src_col(int mat, int np) {
    if (mat < 2) { const int t = np >> 8, bj = (np >> 7) & 1, j = np & 127; return bj * DFF + 128 * t + j; }
    if (mat == 4) {
        const int pn = np >> 8, bj = (np >> 7) & 1, j = np & 127;
        if (pn < 4) return bj * 512 + 128 * pn + j;
        if (pn < 8) { const int base = 1024 + 512 * ((pn - 4) >> 1), head = 2 * (pn & 1) + (j >> 6), e = j & 63; return base + head * 128 + (e < 32 ? e : e + 32) + 32 * bj; }
        return np;
    }
    return np;
}
__device__ void convert_weights(CP p, int layer, LAS unsigned char* lds, int start, int stride, int group, int jlo = 0, int jhi = 1 << 30) {
    const int tid = my_tid();
    bf16_t* WT = (bf16_t*)(p->ws + WS_WT);
    constexpr int LSTR = 264;
    const int ntile0 = group == 0 ? 2624 : (group == 1 ? 2272 : (group == 2 ? 352 : (group == 3 ? 1056 : 1568))), ntile = ntile0 < jhi ? ntile0 : jhi;
    const int kr = tid >> 3, n4 = (tid & 7) * 4;
    for (int j = jlo + start; j < ntile; j += 2 * stride) {
        f32x4 v[2][4]; bf16_t* drow[2]; int dKs[2]; bool ok[2];
#pragma unroll
        for (int u = 0; u < 2; ++u) {
            const int jj = j + u * stride; ok[u] = jj < ntile;
            const int jc = ok[u] ? jj : j;
            const int t = group == 0 ? jc : (group == 1 ? (jc < 1760 ? jc : jc + 352) : (group == 2 ? 1760 + jc : (group == 3 ? (jc < 704 ? jc : 1408 + (jc - 704)) : (jc < 704 ? 704 + jc : 1760 + (jc - 704)))));
            int mat, tl;
            if (t < 1408) { mat = t / 704; tl = t % 704; } else if (t < 2112) { mat = 2 + (t - 1408) / 352; tl = (t - 1408) % 352; } else if (t < 2496) { mat = 4; tl = t - 2112; } else { mat = 5; tl = t - 2496; }
            int Ks, Ns; const float* src; bf16_t* dst;
            if (mat < 2) { Ks = 1024; Ns = 5632; src = p->in[I_W1] + (size_t)(layer * 2 + mat) * 1024 * 5632; dst = WT + WT_W1 + (size_t)mat * 5632 * 1024; }
            else if (mat < 4) { Ks = 2816; Ns = 1024; src = p->in[I_W2] + (size_t)(layer * 2 + mat - 2) * 2816 * 1024; dst = WT + WT_W2 + (size_t)(mat - 2) * 1024 * 2816; }
            else if (mat == 4) { Ks = 1024; Ns = 3072; src = p->in[I_WIN] + (size_t)layer * 1024 * 3072; dst = WT + WT_WIN; }
            else { Ks = 1024; Ns = 1024; src = p->in[I_WOUT] + (size_t)layer * 1024 * 1024; dst = WT + WT_WOUT; }
            const int nkt = Ks >> 8, nt = tl / nkt, kt = tl % nkt;
            const int c0 = wt_src_col(mat, nt * 32);
            drow[u] = dst + (size_t)(nt * 32) * Ks + kt * 256; dKs[u] = Ks;
#pragma unroll
            for (int i = 0; i < 4; ++i) v[u][i] = *(const f32x4*)(src + (size_t)(kt * 256 + kr + 64 * i) * Ns + c0 + n4);
        }
#pragma unroll
        for (int u = 0; u < 2; ++u) {
            LAS bf16_t* L = (LAS bf16_t*)lds + u * (32 * LSTR);
#pragma unroll
            for (int i = 0; i < 4; ++i) {
                const unsigned a = cvt_pk_bf16(v[u][i][0], v[u][i][1]), b = cvt_pk_bf16(v[u][i][2], v[u][i][3]);
                const int k = kr + 64 * i;
                L[(n4 + 0) * LSTR + k] = (bf16_t)(a & 0xffffu); L[(n4 + 1) * LSTR + k] = (bf16_t)(a >> 16);
                L[(n4 + 2) * LSTR + k] = (bf16_t)(b & 0xffffu); L[(n4 + 3) * LSTR + k] = (bf16_t)(b >> 16);
            }
        }
        __syncthreads();
#pragma unroll
        for (int u = 0; u < 2; ++u) {
            if (ok[u]) {
                LAS bf16_t* L = (LAS bf16_t*)lds + u * (32 * LSTR);
                const int n = tid >> 4, kc = (tid & 15) * 16;
                const u32x4v r0 = *(const LAS u32x4v*)(L + n * LSTR + kc), r1 = *(const LAS u32x4v*)(L + n * LSTR + kc + 8);
                bf16_t* d = drow[u] + (size_t)n * dKs[u] + kc;
                *(u32x4v*)d = r0; *(u32x4v*)(d + 8) = r1;
            }
        }
        __syncthreads();
    }
}

__device__ void phase_prep(CP p, LAS unsigned char* lds) {
    const int tid = my_tid();
    float* MOD = (float*)(p->ws + WS_MOD);
    if (blockIdx.x == gridDim.x - 1) {
        float* rope = (float*)(p->ws + WS_ROPE);
        for (int e = tid; e < 2048; e += 512) {
            const int pos = e >> 5, f = e & 31;
            const float inv = exp2f(-(float)f * (13.287712379549449f / 32.0f));
            const float x = (float)pos * inv;
            const float r = x - 6.283185307179586f * rintf(x * 0.15915494309189535f);
            rope[2 * e] = cosf(r); rope[2 * e + 1] = sinf(r);
        }
    }
    if (blockIdx.x < 144) {
        LAS float* S = (LAS float*)lds;
        LAS float* R = (LAS float*)(lds + 9 * 1024 * 4);
        for (int i = tid; i < 9 * 1024; i += 512) {
            const int r = i >> 10, k = i & 1023;
            const float c = r == 0 ? p->in[I_CCTX][k] : p->in[I_C][(r - 1) * 1024 + k];
            S[i] = c / (1.0f + __expf(-c));
        }
        __syncthreads();
        for (int task = blockIdx.x; task < 144; task += gridDim.x) {
            const int l = task / 36, j0 = (task % 36) * 256;
            const int cq = tid & 63, ks = tid >> 6;
            const float* w = p->in[I_WADA] + ((size_t)l * 1024 + ks * 128) * MODW + j0 + 4 * cq;
            f32x4 acc[9];
#pragma unroll
            for (int r = 0; r < 9; ++r) acc[r] = (f32x4){0.f, 0.f, 0.f, 0.f};
#pragma unroll 4
            for (int k = 0; k < 128; ++k) {
                const f32x4 wv = *(const f32x4*)(w + (size_t)k * MODW);
#pragma unroll
                for (int r = 0; r < 9; ++r) acc[r] += wv * S[r * 1024 + ks * 128 + k];
            }
#pragma unroll
            for (int r = 0; r < 9; ++r) *(LAS f32x4*)(R + (ks * 9 + r) * 256 + 4 * cq) = acc[r];
            __syncthreads();
            for (int i = tid; i < 9 * 256; i += 512) {
                const int r = i >> 8, c = i & 255;
                float s = p->in[I_BADA][(size_t)l * MODW + j0 + c];
#pragma unroll
                for (int q = 0; q < 8; ++q) s += R[(q * 9 + r) * 256 + c];
                MOD[((size_t)l * 9 + r) * MODW + j0 + c] = s;
            }
            __syncthreads();
        }
    }
    {
        const bool nomod = blockIdx.x >= 144; const int split = 6 * 112;
        convert_weights(p, 0, lds, nomod ? (int)blockIdx.x - 144 : (int)blockIdx.x, nomod ? 112 : 144, 3, nomod ? 0 : split, nomod ? split : (1 << 30));
    }
    {
        unsigned* cnt = (unsigned*)(p->ws + WS_CNT);
        for (int i = blockIdx.x * 512 + tid; i < N_CNT; i += gridDim.x * 512) cnt[i] = 0u;
    }
}

__device__ void phase_init(CP p) {
    const int tid = my_tid();
    f16x8* XP = (f16x8*)(p->ws + WS_X); bf16_t* H = (bf16_t*)(p->ws + WS_H);
    const float* MOD = (const float*)(p->ws + WS_MOD);
    for (unsigned pc = blockIdx.x * 512 + tid; pc < (unsigned)(T / 256) * 4 * 8 * 16 * 64; pc += gridDim.x * 512) {
        const int lane = pc & 63, g = (pc >> 6) & 15, w = (pc >> 10) & 7, pn = (pc >> 13) & 3, pm = pc >> 15;
        const int fr = lane & 15, fq = lane >> 4, wr = w >> 2, wc = w & 3, ai = g >> 3, bj = (g >> 2) & 1, m = g & 3;
        const int row = pm * 256 + ai * 128 + wr * 64 + m * 16 + fr, col = pn * 256 + bj * 128 + wc * 32 + 8 * fq;
        const float* src = row < T_CTX ? p->in[I_XP] + (size_t)row * D + col : p->in[I_XS] + (size_t)(row - T_CTX) * D + col;
        const f32x4 x0 = *(const f32x4*)src, x1 = *(const f32x4*)(src + 4);
        const f32x8 xv = (f32x8){x0[0], x0[1], x0[2], x0[3], x1[0], x1[1], x1[2], x1[3]};
        XP[pc] = __builtin_convertvector(xv, f16x8);
        const float* mp = MOD + (size_t)mod_row_of_tok(row) * MODW + col;
        const f32x4 h0 = x0 * (*(const f32x4*)(mp + D) + 1.0f) + *(const f32x4*)mp, h1 = x1 * (*(const f32x4*)(mp + D + 4) + 1.0f) + *(const f32x4*)(mp + 4);
        u32x4v o; o[0] = cvt_pk_bf16(h0[0], h0[1]); o[1] = cvt_pk_bf16(h0[2], h0[3]); o[2] = cvt_pk_bf16(h1[0], h1[1]); o[3] = cvt_pk_bf16(h1[2], h1[3]);
        *(u32x4v*)(H + (size_t)row * D + col) = o;
    }
}

__device__ __forceinline__ bf16x8 scale_frag(bf16x8 f, const float (&s)[8]) {
    u32x4v u = __builtin_bit_cast(u32x4v, f), o;
#pragma unroll
    for (int q = 0; q < 4; ++q) o[q] = cvt_pk_bf16(bf_lo(u[q]) * s[2 * q], bf_hi(u[q]) * s[2 * q + 1]);
    return __builtin_bit_cast(bf16x8, o);
}
struct KvSet { bf16x8 a[4]; bf16x8 b[2][4]; };
__device__ void kv_scan_unit(CP p, int layer, int unit) {
    const int tid = my_tid(), w = tid >> 6, lane = tid & 63, l15 = lane & 15, g = lane >> 4;
    int s, h, dir, sl;
    if (unit < 256) { sl = unit & 3; dir = (unit >> 2) & 1; h = (unit >> 3) & 3; s = 32 + (unit >> 5); }
    else { const int u = unit - 256; sl = u & 3; dir = (u >> 2) & 1; h = (u >> 3) & 3; s = u >> 5; }
    const bool lat = s >= 32;
    const int nch = lat ? 32 : 2, chunk0 = lat ? 64 + 32 * (s - 32) : 2 * s;
    const bf16_t* KT = (const bf16_t*)(p->ws + WS_U + 3 * SZ_T512); const bf16_t* VT = (const bf16_t*)(p->ws + WS_U + 4 * SZ_T512);
    bf16_t* RPT = (bf16_t*)(p->ws + WS_RPT);
    const float lg = log_sigmoid_f(p->in[I_DEC][(layer * 2 + dir) * 4 + h]);
    const float cd = __expf(lg * 128.0f);
    float kj[8], kb[4];
#pragma unroll
    for (int j = 0; j < 8; ++j) kj[j] = __expf(lg * (float)(dir == 0 ? -j : j));
#pragma unroll
    for (int kk = 0; kk < 4; ++kk) kb[kk] = __expf(lg * (float)(dir == 0 ? 127 - 32 * kk - 8 * g : 32 * kk + 8 * g));
    const int dk0 = 16 * w + 4 * g;
    f32x4 acc[2];
#pragma unroll
    for (int nb = 0; nb < 2; ++nb) {
        if (lat) {
            const float* r0 = p->in[dir == 0 ? I_SF : I_SB] + ((size_t)((s - 32) * DEPTH + layer) * 4 + h) * 16384;
            const int dv = 32 * sl + 16 * nb + l15;
#pragma unroll
            for (int i = 0; i < 4; ++i) acc[nb][i] = r0[(size_t)(dk0 + i) * 128 + dv];
        } else acc[nb] = (f32x4){0.f, 0.f, 0.f, 0.f};
    }
    const bf16_t* kbase = KT + ((size_t)h * 128 + 16 * w + l15) * 128 + 8 * g;
    const bf16_t* vbase = VT + ((size_t)h * 128 + 32 * sl + l15) * 128 + 8 * g;
    auto chunk_of = [&](int i) { return chunk0 + (dir == 0 ? i : nch - 1 - i); };
    auto load_set = [&](KvSet& S, int i) {
        const size_t co = (size_t)chunk_of(i) * 4 * 16384;
#pragma unroll
        for (int kk = 0; kk < 4; ++kk) {
            S.a[kk] = *(const bf16x8*)(kbase + co + 32 * kk);
            S.b[0][kk] = *(const bf16x8*)(vbase + co + 32 * kk);
            S.b[1][kk] = *(const bf16x8*)(vbase + co + 16 * 128 + 32 * kk);
        }
    };
    auto step = [&](const KvSet& S, int i) {
        const int chunk = chunk_of(i);
#pragma unroll
        for (int nb = 0; nb < 2; ++nb) {
            const int dv = 32 * sl + 16 * nb + l15;
            u32x2 o; o[0] = cvt_pk_bf16(acc[nb][0], acc[nb][1]); o[1] = cvt_pk_bf16(acc[nb][2], acc[nb][3]);
            *(u32x2*)(RPT + (((size_t)(dir * NCHUNK + chunk) * 4 + h) * 128 + dv) * 128 + dk0) = o;
            acc[nb] *= cd;
        }
#pragma unroll
        for (int kk = 0; kk < 4; ++kk) {
            float sc[8];
#pragma unroll
            for (int j = 0; j < 8; ++j) sc[j] = kb[kk] * kj[j];
            const bf16x8 ak = scale_frag(S.a[kk], sc);
#pragma unroll
            for (int nb = 0; nb < 2; ++nb) acc[nb] = __builtin_amdgcn_mfma_f32_16x16x32_bf16(ak, S.b[nb][kk], acc[nb], 0, 0, 0);
        }
    };
    KvSet s0, s1, s2;
    load_set(s0, 0); load_set(s1, 1);
    for (int i = 0; i < nch; i += 3) {
        if (i + 2 < nch) load_set(s2, i + 2);
        step(s0, i);
        if (i + 1 < nch) { if (i + 3 < nch) load_set(s0, i + 3); step(s1, i + 1); }
        if (i + 2 < nch) { if (i + 4 < nch) load_set(s1, i + 4); step(s2, i + 2); }
    }
    if (!lat) {
        float* o = p->out + (dir == 0 ? OUT_SF : OUT_SB) + ((size_t)(s * DEPTH + layer) * 4 + h) * 16384;
#pragma unroll
        for (int nb = 0; nb < 2; ++nb) {
            const int dv = 32 * sl + 16 * nb + l15;
#pragma unroll
            for (int i = 0; i < 4; ++i) o[(size_t)(dk0 + i) * 128 + dv] = acc[nb][i];
        }
    }
}
__device__ void conv_units(CP p, int layer, LAS unsigned char* lds) {
    const int tid = my_tid(), lane = tid & 63, w = tid >> 6;
    const bf16_t* UPRE = (const bf16_t*)(p->ws + WS_U);
    bf16_t* MIX = (bf16_t*)(p->ws + WS_MIX);
    LAS unsigned char* lin = lds; LAS unsigned char* lout = lds + 62 * 1024;
    const int cp = tid & 255, th = tid >> 8;
    const float* cw = p->in[I_CW] + (size_t)layer * 31 * 512 + 2 * cp;
    f32x2 wgt[31];
#pragma unroll
    for (int j = 0; j < 31; ++j) wgt[j] = *(const f32x2*)(cw + (size_t)j * 512);
    const f32x2 bias = *(const f32x2*)(p->in[I_CB] + (size_t)layer * 512 + 2 * cp);
    const float* lg = p->in[I_CLG] + (size_t)layer * 512; const float* lb = p->in[I_CLB] + (size_t)layer * 512;
    const f32x4 g0 = *(const f32x4*)(lg + 4 * lane), g1 = *(const f32x4*)(lg + 256 + 4 * lane), b0 = *(const f32x4*)(lb + 4 * lane), b1 = *(const f32x4*)(lb + 256 + 4 * lane);
    u32x4v pre[8];
    auto issue = [&](int cu) {
        const int tok0 = cu * 32;
        int seg0, seg1;
        if (tok0 < T_CTX) { seg0 = tok0 & ~255; seg1 = seg0 + 256; } else { seg0 = tok0 & ~63; seg1 = seg0 + 64; }
#pragma unroll
        for (int k = 0; k < 8; ++k) {
            const int idx = tid + 512 * k, row = idx >> 6, ch = idx & 63, gr = tok0 - 15 + row;
            u32x4v v = (u32x4v){0u, 0u, 0u, 0u};
            if (idx < 62 * 64 && gr >= seg0 && gr < seg1) v = *(const u32x4v*)(UPRE + (size_t)gr * 512 + ch * 8);
            pre[k] = v;
        }
    };
    int cu = blockIdx.x;
    if (cu < 1280) issue(cu);
    for (; cu < 1280; cu += gridDim.x) {
        const int tok0 = cu * 32;
#pragma unroll
        for (int k = 0; k < 8; ++k) { const int idx = tid + 512 * k; if (idx < 62 * 64) *(LAS u32x4v*)(lin + (idx >> 6) * 1024 + (idx & 63) * 16) = pre[k]; }
        __syncthreads();
        if (cu + (int)gridDim.x < 1280) issue(cu + gridDim.x);
        f32x2 o[16];
#pragma unroll
        for (int t = 0; t < 16; ++t) o[t] = bias;
#pragma unroll
        for (int s = 0; s < 46; ++s) {
            const unsigned u = *(const LAS unsigned*)(lin + (16 * th + s) * 1024 + cp * 4);
            const f32x2 x = (f32x2){bf_lo(u), bf_hi(u)};
#pragma unroll
            for (int t = 0; t < 16; ++t) { if (s - t >= 0 && s - t <= 30) o[t] += wgt[s - t] * x; }
        }
#pragma unroll
        for (int t = 0; t < 16; ++t) *(LAS f32x2*)(lout + (16 * th + t) * 2048 + cp * 8) = o[t];
        __syncthreads();
#pragma unroll 2
        for (int tt = 0; tt < 4; ++tt) {
            const int t = 4 * w + tt;
            f32x4 v0 = *(const LAS f32x4*)(lout + t * 2048 + lane * 16), v1 = *(const LAS f32x4*)(lout + t * 2048 + 1024 + lane * 16);
            const float mu = wave_sum(v0[0] + v0[1] + v0[2] + v0[3] + v1[0] + v1[1] + v1[2] + v1[3]) * (1.0f / 512.0f);
            v0 -= mu; v1 -= mu;
            const float var = wave_sum(v0[0] * v0[0] + v0[1] * v0[1] + v0[2] * v0[2] + v0[3] * v0[3] + v1[0] * v1[0] + v1[1] * v1[1] + v1[2] * v1[2] + v1[3] * v1[3]) * (1.0f / 512.0f);
            const float rstd = rsqrtf(var + EPS_F);
            v0 = v0 * rstd * g0 + b0; v1 = v1 * rstd * g1 + b1;
            u32x2 q0, q1;
            q0[0] = cvt_pk_bf16(fast_silu(v0[0]), fast_silu(v0[1])); q0[1] = cvt_pk_bf16(fast_silu(v0[2]), fast_silu(v0[3]));
            q1[0] = cvt_pk_bf16(fast_silu(v1[0]), fast_silu(v1[1])); q1[1] = cvt_pk_bf16(fast_silu(v1[2]), fast_silu(v1[3]));
            bf16_t* dst = MIX + (size_t)(tok0 + t) * D;
            *(u32x2*)(dst + 4 * lane) = q0; *(u32x2*)(dst + 256 + 4 * lane) = q1;
        }
    }
    __syncthreads();
}
struct KvStep { int lat, s, h, dir, sl, i, nch, chunk; };
__device__ __forceinline__ KvStep kv_step(int j) {
    KvStep k; int u;
    if (j < 32) { u = blockIdx.x; k.lat = 1; k.i = j; k.nch = 32; k.s = 32 + (u >> 5); }
    else { u = blockIdx.x + 256 * ((j - 32) >> 1); k.lat = 0; k.i = (j - 32) & 1; k.nch = 2; k.s = u >> 5; }
    k.sl = u & 3; k.dir = (u >> 2) & 1; k.h = (u >> 3) & 3;
    const int chunk0 = k.lat ? 64 + 32 * (k.s - 32) : 2 * k.s;
    k.chunk = chunk0 + (k.dir == 0 ? k.i : k.nch - 1 - k.i);
    return k;
}
struct KvRegs { bf16x8 a[4]; u32x4v b; };
__device__ void kv_scan_stream(CP p, int layer, LAS unsigned char* lds) {
    const int tid = my_tid(), w = tid >> 6, lane = tid & 63, l15 = lane & 15, g = lane >> 4;
    const bf16_t* KT = (const bf16_t*)(p->ws + WS_U + 3 * SZ_T512); const bf16_t* VT = (const bf16_t*)(p->ws + WS_U + 4 * SZ_T512);
    bf16_t* RPT = (bf16_t*)(p->ws + WS_RPT);
    constexpr int NSTEP = 40, BRS = 272, BSLOT = 32 * BRS;
    const int dk0 = 16 * w + 4 * g;
    auto issue = [&](KvRegs& S, int j) {
        const KvStep k = kv_step(j);
        const bf16_t* kb = KT + ((size_t)(k.chunk * 4 + k.h) * 128 + 16 * w + l15) * 128 + 8 * g;
#pragma unroll
        for (int kk = 0; kk < 4; ++kk) S.a[kk] = *(const bf16x8*)(kb + 32 * kk);
        S.b = *(const u32x4v*)(VT + ((size_t)(k.chunk * 4 + k.h) * 128 + 32 * k.sl + (tid >> 4)) * 128 + (tid & 15) * 8);
    };
    f32x4 acc[2] = {(f32x4){0.f, 0.f, 0.f, 0.f}, (f32x4){0.f, 0.f, 0.f, 0.f}};
    float cd = 0.f, kj[8], kb4[4];
#pragma unroll
    for (int j = 0; j < 8; ++j) kj[j] = 0.f;
#pragma unroll
    for (int kk = 0; kk < 4; ++kk) kb4[kk] = 0.f;
    auto body = [&](KvRegs& S, int j) {
        const KvStep k = kv_step(j);
        LAS unsigned char* slot = lds + (j & 1) * BSLOT;
        *(LAS u32x4v*)(slot + (tid >> 4) * BRS + (tid & 15) * 16) = S.b;
        __syncthreads();
        if (k.i == 0) {
            const float lg = log_sigmoid_f(p->in[I_DEC][(layer * 2 + k.dir) * 4 + k.h]);
            cd = __expf(lg * 128.0f);
#pragma unroll
            for (int jj = 0; jj < 8; ++jj) kj[jj] = __expf(lg * (float)(k.dir == 0 ? -jj : jj));
#pragma unroll
            for (int kk = 0; kk < 4; ++kk) kb4[kk] = __expf(lg * (float)(k.dir == 0 ? 127 - 32 * kk - 8 * g : 32 * kk + 8 * g));
#pragma unroll
            for (int nb = 0; nb < 2; ++nb) {
                if (k.lat) {
                    const float* r0 = p->in[k.dir == 0 ? I_SF : I_SB] + ((size_t)((k.s - 32) * DEPTH + layer) * 4 + k.h) * 16384;
                    const int dv = 32 * k.sl + 16 * nb + l15;
#pragma unroll
                    for (int i = 0; i < 4; ++i) acc[nb][i] = r0[(size_t)(dk0 + i) * 128 + dv];
                } else acc[nb] = (f32x4){0.f, 0.f, 0.f, 0.f};
            }
        }
#pragma unroll
        for (int nb = 0; nb < 2; ++nb) {
            const int dv = 32 * k.sl + 16 * nb + l15;
            u32x2 o; o[0] = cvt_pk_bf16(acc[nb][0], acc[nb][1]); o[1] = cvt_pk_bf16(acc[nb][2], acc[nb][3]);
            *(u32x2*)(RPT + (((size_t)(k.dir * NCHUNK + k.chunk) * 4 + k.h) * 128 + dv) * 128 + dk0) = o;
            acc[nb] *= cd;
        }
#pragma unroll
        for (int kk = 0; kk < 4; ++kk) {
            float sc[8];
#pragma unroll
            for (int jj = 0; jj < 8; ++jj) sc[jj] = kb4[kk] * kj[jj];
            const bf16x8 ak = scale_frag(S.a[kk], sc);
#pragma unroll
            for (int nb = 0; nb < 2; ++nb) {
                const bf16x8 bfr = *(const LAS bf16x8*)(slot + (16 * nb + l15) * BRS + (32 * kk + 8 * g) * 2);
                acc[nb] = __builtin_amdgcn_mfma_f32_16x16x32_bf16(ak, bfr, acc[nb], 0, 0, 0);
            }
        }
        if (!k.lat && k.i == k.nch - 1) {
            float* o = p->out + (k.dir == 0 ? OUT_SF : OUT_SB) + ((size_t)(k.s * DEPTH + layer) * 4 + k.h) * 16384;
#pragma unroll
            for (int nb = 0; nb < 2; ++nb) {
                const int dv = 32 * k.sl + 16 * nb + l15;
#pragma unroll
                for (int i = 0; i < 4; ++i) o[(size_t)(dk0 + i) * 128 + dv] = acc[nb][i];
            }
        }
        if (j + 5 < NSTEP) issue(S, j + 5);
    };
    KvRegs s0, s1, s2, s3, s4;
    issue(s0, 0); issue(s1, 1); issue(s2, 2); issue(s3, 3); issue(s4, 4);
    for (int j = 0; j < NSTEP; j += 5) { body(s0, j); body(s1, j + 1); body(s2, j + 2); body(s3, j + 3); body(s4, j + 4); }
    __syncthreads();
}
__device__ void phase_mix2(CP p, int layer, LAS unsigned char* lds) {
    kv_scan_stream(p, layer, lds);
    conv_units(p, layer, lds);
}

__device__ void phase_mix3(CP p, int layer, LAS unsigned char* lds) {
    const int tid = my_tid(), w = tid >> 6, lane = tid & 63, l15 = lane & 15, g = lane >> 4;
    const bf16_t* Q = (const bf16_t*)(p->ws + WS_U + 1 * SZ_T512); const bf16_t* K = (const bf16_t*)(p->ws + WS_U + 2 * SZ_T512);
    const bf16_t* VT = (const bf16_t*)(p->ws + WS_U + 4 * SZ_T512); const bf16_t* SG = (const bf16_t*)(p->ws + WS_U + 5 * SZ_T512);
    const bf16_t* RPT = (const bf16_t*)(p->ws + WS_RPT);
    bf16_t* MIX = (bf16_t*)(p->ws + WS_MIX);
    constexpr int RS = 272, BUF = 128 * RS;
    LAS unsigned char* Ks = lds; LAS unsigned char* VTs = lds + BUF; LAS unsigned char* RfT = lds + 2 * BUF; LAS unsigned char* RbT = lds + 3 * BUF;
    u32x4v pre[16]; bf16x8 qpre[4];
    auto issue = [&](int pt) {
        const int chunk = pt >> 2, h = pt & 3, tok0 = chunk * 128;
#pragma unroll
        for (int i = 0; i < 4; ++i) {
            const int idx = tid + 512 * i, row = idx >> 4, ch = idx & 15;
            pre[4 * i + 0] = *(const u32x4v*)(K + (size_t)(tok0 + row) * 512 + h * 128 + ch * 8);
            pre[4 * i + 1] = *(const u32x4v*)(VT + ((size_t)(chunk * 4 + h) * 128 + row) * 128 + ch * 8);
            pre[4 * i + 2] = *(const u32x4v*)(RPT + (((size_t)chunk * 4 + h) * 128 + row) * 128 + ch * 8);
            pre[4 * i + 3] = *(const u32x4v*)(RPT + (((size_t)(NCHUNK + chunk) * 4 + h) * 128 + row) * 128 + ch * 8);
        }
#pragma unroll
        for (int kk = 0; kk < 4; ++kk) qpre[kk] = *(const bf16x8*)(Q + (size_t)(tok0 + 16 * w + l15) * 512 + h * 128 + 32 * kk + 8 * g);
    };
    if ((int)blockIdx.x < NCHUNK * 4) issue(blockIdx.x);
    for (int pt = blockIdx.x; pt < NCHUNK * 4; pt += gridDim.x) {
        const int chunk = pt >> 2, h = pt & 3, tok0 = chunk * 128;
#pragma unroll
        for (int i = 0; i < 4; ++i) {
            const int idx = tid + 512 * i, row = idx >> 4, ch = idx & 15;
            *(LAS u32x4v*)(Ks + row * RS + ch * 16) = pre[4 * i + 0]; *(LAS u32x4v*)(VTs + row * RS + ch * 16) = pre[4 * i + 1];
            *(LAS u32x4v*)(RfT + row * RS + ch * 16) = pre[4 * i + 2]; *(LAS u32x4v*)(RbT + row * RS + ch * 16) = pre[4 * i + 3];
        }
        int c = 16 * w + l15;
        asm volatile("" : "+v"(c));
        bf16x8 qf[4], qff[4], qfb[4];
        const float lgf = log_sigmoid_f(p->in[I_DEC][(layer * 2 + 0) * 4 + h]), lgb = log_sigmoid_f(p->in[I_DEC][(layer * 2 + 1) * 4 + h]);
        const float lf2 = lgf * 1.4426950408889634f, lb2 = lgb * 1.4426950408889634f;
#pragma unroll
        for (int kk = 0; kk < 4; ++kk) qf[kk] = qpre[kk];
        __syncthreads();
        if (pt + (int)gridDim.x < NCHUNK * 4) issue(pt + gridDim.x);
        u32x2 sgv[8];
        {
            const bf16_t* sgq = SG + (size_t)(tok0 + c) * 512 + h * 128 + 4 * g;
#pragma unroll
            for (int mb = 0; mb < 8; ++mb) sgv[mb] = *(const u32x2*)(sgq + 16 * mb);
        }
        u32x4v pf[4];
#pragma unroll
        for (int t = 0; t < 8; ++t) {
            f32x4 sacc = (f32x4){0.f, 0.f, 0.f, 0.f};
#pragma unroll
            for (int kk = 0; kk < 4; ++kk) {
                const bf16x8 a = *(const LAS bf16x8*)(Ks + (16 * t + l15) * RS + (32 * kk + 8 * g) * 2);
                sacc = __builtin_amdgcn_mfma_f32_16x16x32_bf16(a, qf[kk], sacc, 0, 0, 0);
            }
#pragma unroll
            for (int i = 0; i < 4; ++i) {
                const float dist = (float)(c - (16 * t + 4 * g + i));
                const float df = __builtin_amdgcn_exp2f(fmaf(lf2, dist, -1000.0f * fmaxf(-dist, 0.f))), db = __builtin_amdgcn_exp2f(fmaf(-lb2, dist, -1000.0f * fmaxf(dist, 0.f)));
                sacc[i] *= (df + db);
            }
            pf[t >> 1][2 * (t & 1)] = cvt_pk_bf16(sacc[0], sacc[1]); pf[t >> 1][2 * (t & 1) + 1] = cvt_pk_bf16(sacc[2], sacc[3]);
            if (t & 1) __builtin_amdgcn_sched_barrier(0);
        }
        f32x4 o[8];
#pragma unroll
        for (int mb = 0; mb < 8; ++mb) o[mb] = (f32x4){0.f, 0.f, 0.f, 0.f};
#pragma unroll
        for (int s = 0; s < 4; ++s) {
            const bf16x8 pb = __builtin_bit_cast(bf16x8, pf[s]);
#pragma unroll
            for (int mb = 0; mb < 8; ++mb) {
                const u32x2 lo = *(const LAS u32x2*)(VTs + (16 * mb + l15) * RS + (32 * s + 4 * g) * 2), hi = *(const LAS u32x2*)(VTs + (16 * mb + l15) * RS + (32 * s + 16 + 4 * g) * 2);
                const u32x4v av = (u32x4v){lo[0], lo[1], hi[0], hi[1]};
                o[mb] = __builtin_amdgcn_mfma_f32_16x16x32_bf16(__builtin_bit_cast(bf16x8, av), pb, o[mb], 0, 0, 0);
            }
            __builtin_amdgcn_sched_barrier(0);
        }
        __builtin_amdgcn_sched_barrier(0);
        {
            const float df = __expf(lgf * (float)(c + 1)), db = __expf(lgb * (float)(128 - c));
            float sf[8], sb[8];
#pragma unroll
            for (int j = 0; j < 8; ++j) { sf[j] = df; sb[j] = db; }
#pragma unroll
            for (int kk = 0; kk < 4; ++kk) { qff[kk] = scale_frag(qf[kk], sf); qfb[kk] = scale_frag(qf[kk], sb); }
        }
#pragma unroll
        for (int kk = 0; kk < 4; ++kk)
#pragma unroll
            for (int mb = 0; mb < 8; ++mb) {
                const bf16x8 af = *(const LAS bf16x8*)(RfT + (16 * mb + l15) * RS + (32 * kk + 8 * g) * 2);
                o[mb] = __builtin_amdgcn_mfma_f32_16x16x32_bf16(af, qff[kk], o[mb], 0, 0, 0);
                const bf16x8 ab = *(const LAS bf16x8*)(RbT + (16 * mb + l15) * RS + (32 * kk + 8 * g) * 2);
                o[mb] = __builtin_amdgcn_mfma_f32_16x16x32_bf16(ab, qfb[kk], o[mb], 0, 0, 0);
                if (mb == 3 || mb == 7) __builtin_amdgcn_sched_barrier(0);
            }
        float s1 = 0.f;
#pragma unroll
        for (int mb = 0; mb < 8; ++mb) s1 += o[mb][0] + o[mb][1] + o[mb][2] + o[mb][3];
        s1 += __shfl_xor(s1, 16, 64); s1 += __shfl_xor(s1, 32, 64);
        const float mu = s1 * (1.0f / 128.0f);
        float s2 = 0.f;
#pragma unroll
        for (int mb = 0; mb < 8; ++mb) { o[mb] -= mu; s2 += o[mb][0] * o[mb][0] + o[mb][1] * o[mb][1] + o[mb][2] * o[mb][2] + o[mb][3] * o[mb][3]; }
        s2 += __shfl_xor(s2, 16, 64); s2 += __shfl_xor(s2, 32, 64);
        const float rstd = rsqrtf(s2 * (1.0f / 128.0f) + EPS_F);
        bf16_t* dst = MIX + (size_t)(tok0 + c) * D + 512 + h * 128 + 4 * g;
#pragma unroll
        for (int mb = 0; mb < 8; ++mb) {
            const u32x2 sg = sgv[mb];
            u32x2 r;
            r[0] = cvt_pk_bf16(o[mb][0] * rstd * bf_lo(sg[0]), o[mb][1] * rstd * bf_hi(sg[0]));
            r[1] = cvt_pk_bf16(o[mb][2] * rstd * bf_lo(sg[1]), o[mb][3] * rstd * bf_hi(sg[1]));
            *(u32x2*)(dst + 16 * mb) = r;
        }
        __syncthreads();
    }
}

#define XB_TMO      128
#define XB_XCNT(j)  (256  + 64 * (j))
#define XB_XSUB(j)  (1280 + 64 * (j))
#define XB_XGEN(j)  (2304 + 64 * (j))
#define XB_TOP      3328
#define XB_TOPGEN   3392
#define XCD_BAR_WORDS 3456
#define XB_SPIN_CAP (1u << 18)

__device__ __forceinline__ unsigned xb_ld(unsigned* p)              { return __hip_atomic_load(p, __ATOMIC_RELAXED, __HIP_MEMORY_SCOPE_AGENT); }
__device__ __forceinline__ unsigned xb_add(unsigned* p, unsigned v) { return __hip_atomic_fetch_add(p, v, __ATOMIC_RELAXED, __HIP_MEMORY_SCOPE_AGENT); }
__device__ __forceinline__ unsigned xb_xcc_id() { return (unsigned)__builtin_amdgcn_s_getreg((3 << 11) | 20) & 0xFu; }
#define XB_SPIN(cond, bar) do { unsigned _sp = 0; while (cond) { __builtin_amdgcn_s_sleep(1); \
    if ((++_sp & 255u) == 0u) { if (xb_ld(&(bar)[XB_TMO])) break; if (_sp > XB_SPIN_CAP) { atomicAdd(&(bar)[XB_TMO], 1u); break; } } } } while (0)
struct XcdBarrier {
    unsigned* bar; unsigned x;
    volatile LAS unsigned* st;
};

__device__ __forceinline__ XcdBarrier xcd_barrier_post(unsigned* bar, volatile LAS unsigned* st) {
    XcdBarrier b; b.bar = bar; b.x = xb_xcc_id(); b.st = st;
    if (threadIdx.x == 0) (void)xb_add(&bar[XB_XCNT(b.x)], 1u);
    return b;
}
__device__ __forceinline__ void xcd_barrier_complete(unsigned* bar, unsigned x, unsigned& nloc, unsigned& nx) {
    const unsigned G = gridDim.x * gridDim.y * gridDim.z;
    unsigned sum, cnt, mine, sp = 0u;
    for (;;) {
        sum = 0u; cnt = 0u; mine = 0u;
#pragma unroll
        for (unsigned j = 0; j < 16; ++j) { const unsigned c = xb_ld(&bar[XB_XCNT(j)]); sum += c; cnt += (c > 0u) ? 1u : 0u; mine = (j == x) ? c : mine; }
        if (sum == G) break;
        __builtin_amdgcn_s_sleep(1);
        if ((++sp & 255u) == 0u) { if (xb_ld(&bar[XB_TMO])) break; if (sp > XB_SPIN_CAP) { atomicAdd(&bar[XB_TMO], 1u); break; } }
    }
    nloc = mine > 0u ? mine : 1u; nx = cnt > 0u ? cnt : 1u;
}

__device__ __forceinline__ void xcd_barrier(const XcdBarrier& b) {
    asm volatile("s_waitcnt vmcnt(0)" ::: "memory");
    __syncthreads();
    if (threadIdx.x == 0) {
        unsigned* bar = b.bar; asm volatile("" : "+s"(bar));
        __builtin_amdgcn_s_waitcnt(0);
        unsigned nloc = b.st[0], nx = b.st[1];
        if (nloc == 0u) { xcd_barrier_complete(bar, b.x, nloc, nx); b.st[0] = nloc; b.st[1] = nx; }
        const unsigned old = xb_add(&bar[XB_XSUB(b.x)], 1u);
        const unsigned gen = old / nloc;
        if (old + 1u == (gen + 1u) * nloc) {
            __builtin_amdgcn_fence(__ATOMIC_RELEASE, "agent");
            asm volatile("s_waitcnt vmcnt(0)" ::: "memory");
            const unsigned og = xb_add(&bar[XB_TOP], 1u);
            const unsigned tg = og / nx;
            if (og + 1u == (tg + 1u) * nx) xb_add(&bar[XB_TOPGEN], 1u);
            else XB_SPIN(xb_ld(&bar[XB_TOPGEN]) == tg, bar);
            __builtin_amdgcn_fence(__ATOMIC_ACQUIRE, "agent");
            xb_add(&bar[XB_XGEN(b.x)], 1u);
            asm volatile("s_waitcnt vmcnt(0)" ::: "memory");
        } else {
            XB_SPIN(xb_ld(&bar[XB_XGEN(b.x)]) == gen, bar);
            __builtin_amdgcn_fence(__ATOMIC_ACQUIRE, "agent");
            asm volatile("s_waitcnt vmcnt(0)" ::: "memory");
        }
    }
    __syncthreads();
}


constexpr int PPL = 8;
constexpr int N_PHASES = 2 + PPL * DEPTH;
#ifndef PHM
#define PHM 0xffff
#endif
__device__ __forceinline__ void run_phase(CP p, int ph, LAS unsigned char* lds, bool dry) {
    bf16_t* WT = (bf16_t*)(p->ws + WS_WT);
    bf16_t* H = (bf16_t*)(p->ws + WS_H); bf16_t* MIX = (bf16_t*)(p->ws + WS_MIX); bf16_t* ACT = (bf16_t*)(p->ws + WS_U);
    const float* MOD = (const float*)(p->ws + WS_MOD);
    if (ph == 0) { if (PHM & 1) phase_prep(p, lds); return; }
    if (ph == 1) { if (PHM & 2) phase_init(p); return; }
    const int l = (ph - 2) / PPL, s = (ph - 2) % PPL;
    if ((PHM & 4) && (s == 0 || s == 6)) {
        pg8::StaticOrder S;
        pg8::Gemm gm{H, WT + WT_W1 + (size_t)(s == 6) * 5632 * 1024, T, 2 * DFF, D};
        S.init(gm.M, gm.N, (int)gridDim.x, (int)blockIdx.x);
        EpiSwiglu E{ACT};
        pg8::gemm_phase<EpiSwiglu, pg8::StaticOrder>(lds, gm, S, E);
    } else if ((PHM & 8) && (s == 1 || s == 7 || s == 5)) {
        const int sub = s == 1 ? 0 : (s == 5 ? 1 : 2);
        const pg8::Gemm gm{s == 5 ? MIX : ACT, s == 5 ? WT + WT_WOUT : WT + WT_W2 + (size_t)(s == 7) * 1024 * 2816, T, D, s == 5 ? D : DFF};
        const EpiResLn E{p, l, sub};
        QuadOrder S; S.init(gm.M, (int)blockIdx.x);
        pg8::gemm_phase<EpiResLn, QuadOrder>(lds, gm, S, E);
        if (s == 7 && l + 1 < DEPTH && (blockIdx.x >> 3) >= 16) convert_weights(p, l + 1, lds, (int)(blockIdx.x & 7) + 8 * ((int)(blockIdx.x >> 3) - 16), 128, 1);
        if (s == 1 && (blockIdx.x >> 3) >= 16) convert_weights(p, l, lds, (int)(blockIdx.x & 7) + 8 * ((int)(blockIdx.x >> 3) - 16), 128, l > 0 ? 2 : 4);
    } else if ((PHM & 16) && s == 2) {
        pg8::StaticOrder S;
        pg8::Gemm gm{H, WT + WT_WIN, T, DIN, D};
        S.init(gm.M, gm.N, (int)gridDim.x, (int)blockIdx.x);
        bf16_t* U = (bf16_t*)(p->ws + WS_U);
        EpiMixIn E{U, U + (size_t)T * 512, U + (size_t)2 * T * 512, U + (size_t)3 * T * 512, U + (size_t)4 * T * 512, U + (size_t)5 * T * 512, (const float*)(p->ws + WS_ROPE)};
        pg8::gemm_phase<EpiMixIn, pg8::StaticOrder>(lds, gm, S, E);
    }
    else if ((PHM & 32) && s == 3) { phase_mix2(p, l, lds); }
    else if ((PHM & 64) && s == 4) { phase_mix3(p, l, lds); }
}

#ifndef DUPM
#define DUPM 0
#endif
__global__ __launch_bounds__(512, 2) void mega_fwd(Params p) {
    extern __shared__ __attribute__((aligned(16))) unsigned char shm[];
    LAS unsigned char* lds = (LAS unsigned char*)shm;
    volatile LAS unsigned* st = (volatile LAS unsigned*)(lds + LDS_WORK);
    if (threadIdx.x < 2) st[threadIdx.x] = 0u;
    __syncthreads();
    const XcdBarrier xb = xcd_barrier_post((unsigned*)(p.ws + WS_BAR), st);
    for (int ph = p.ph_lo; ph < p.ph_hi; ++ph) {
        if (ph > p.ph_lo) {
            if (ph == 1) cg::this_grid().sync();
            else xcd_barrier(xb);
            if (DUPM & 64) xcd_barrier(xb);
        }
        int nrep = 1;
        if (DUPM) {
            const int s = ph >= 2 ? (ph - 2) % PPL : -1;
            if (((DUPM & 1) && s == 0) || ((DUPM & 2) && s == 2) || ((DUPM & 4) && s == 3) || ((DUPM & 8) && s == 4) || ((DUPM & 32) && ph == 0)) nrep = 2;
        }
        for (int rep = 0; rep < nrep; ++rep) {
            CP pp = (CP)__builtin_amdgcn_kernarg_segment_ptr();
            asm volatile("" : "+s"(pp));
            run_phase(pp, ph, lds, rep + 1 < nrep);
            if (rep + 1 < nrep) __syncthreads();
        }
    }
}

extern "C" void kernel_launch(void* const* d_in, const int* in_sizes, int n_in, void* d_out, int out_size, void* d_ws, size_t ws_size, hipStream_t stream) {
    static int grid = 0;
    if (grid == 0) {
        if (n_in != 19 || ws_size < WS_END) { fprintf(stderr, "kernel_launch: need 19 inputs and >= %zu bytes of workspace; got %d, %zu\n", (size_t)WS_END, n_in, ws_size); grid = -1; return; }
        int dev = 0, cus = 0, per_cu = 0;
        hipGetDevice(&dev);
        hipDeviceGetAttribute(&cus, hipDeviceAttributeMultiprocessorCount, dev);
        if (hipFuncSetAttribute((const void*)mega_fwd, hipFuncAttributeMaxDynamicSharedMemorySize, LDS_BYTES) != hipSuccess) { fprintf(stderr, "kernel_launch: hipFuncSetAttribute failed\n"); grid = -1; return; }
        if (hipOccupancyMaxActiveBlocksPerMultiprocessor(&per_cu, (const void*)mega_fwd, 512, LDS_BYTES) != hipSuccess || per_cu < 1) { fprintf(stderr, "kernel_launch: occupancy query says %d\n", per_cu); per_cu = 1; }
        (void)hipGetLastError();
        grid = cus * 1;
        if (grid != 256) { fprintf(stderr, "kernel_launch: built for 256 CUs, found %d\n", cus); grid = -1; return; }
    }
    if (grid < 0) return;
    (void)hipMemsetAsync((unsigned char*)d_ws + WS_BAR, 0, 3456 * 4, stream);
    Params p{};
    for (int i = 0; i < 19; ++i) p.in[i] = (const float*)d_in[i];
    p.out = (float*)d_out; p.ws = (unsigned char*)d_ws;
#if MK_PER_PHASE
    for (int ph = 0; ph < N_PHASES; ++ph) {
        p.ph_lo = ph; p.ph_hi = ph + 1;
        hipLaunchKernelGGL(mega_fwd, dim3(grid), dim3(512), LDS_BYTES, stream, p);
    }
#else
    p.ph_lo = 0; p.ph_hi = N_PHASES;
    void* args[] = {&p};
    hipError_t e = hipLaunchCooperativeKernel((const void*)mega_fwd, dim3(grid), dim3(512), args, LDS_BYTES, stream);
    if (e != hipSuccess) fprintf(stderr, "cooperative launch failed: %s (grid %d)\n", hipGetErrorString(e), grid);
#endif
}
```

```cpp
#include <hip/hip_runtime.h>
#include <hip/hip_cooperative_groups.h>
#include <cstdio>
namespace cg = cooperative_groups;

#ifndef MK_PER_PHASE
#define MK_PER_PHASE 0
#endif

namespace pg8 {
#define PG8_LAS __attribute__((address_space(3)))
typedef unsigned short bf16_t;
typedef short bf16x8 __attribute__((ext_vector_type(8)));
typedef float f32x4 __attribute__((ext_vector_type(4)));
typedef unsigned u32x4 __attribute__((ext_vector_type(4)));
constexpr int BM = 256, BK = 64, HALF = 128, HTB = HALF * BK * 2, STAGE_BYTES = 8 * HTB, NXCD = 8, WGM = 8;
__host__ __device__ __forceinline__ int lds_byte(int r, int c) { const int st = (r >> 4) * 2 + (c >> 5), rr = r & 15, cc = c & 31, ob = rr * 64 + cc * 2; return st * 1024 + (ob ^ (((ob >> 9) & 1) << 5)); }
__host__ __device__ __forceinline__ void stage_rc(int b, int& R, int& C) { const int st = b / 1024, sb = b % 1024, swz = sb ^ (((sb >> 9) & 1) << 5); R = (st >> 1) * 16 + swz / 64; C = (st & 1) * 32 + (swz % 64) / 2; }
__host__ __device__ __forceinline__ int perm32(int rho) { const int n = rho >> 4, i = rho & 15; return 8 * (i >> 2) + 4 * n + (i & 3); }
struct Unit { int pm, pn; };
struct Gemm { const bf16_t* A; const bf16_t* Bt; int M, N, K; };
struct StaticOrder {
    int nM, nN, nwg, G, c;
    __host__ __device__ void init(int M, int N, int G_, int c_) { nM = M / BM; nN = N / BM; nwg = nM * nN; G = G_; c = c_; }
    __host__ __device__ bool next(int i, Unit& u) const {
        const long L = (long)i * G + c; if (L >= nwg) return false;
        int wgid = (int)L; { const int q = nwg / NXCD, r = nwg % NXCD, xcd = wgid % NXCD, off = wgid / NXCD; wgid = (xcd < r ? xcd * (q + 1) : r * (q + 1) + (xcd - r) * q) + off; }
        const int nig = WGM * nN, gid = wgid / nig, fm = gid * WGM, gsz = (nM - fm) < WGM ? (nM - fm) : WGM;
        u.pm = fm + ((wgid % nig) % gsz); u.pn = (wgid % nig) / gsz; return true;
    }
    __device__ __forceinline__ void a_ready(const Unit&) const {}
    __device__ __forceinline__ void done(const Unit&) const {}
};
template <class Epi, class Sched>
__device__ __forceinline__ void gemm_phase(PG8_LAS unsigned char* lds, const Gemm g, const Sched& S, const Epi& E) {
    int tid_ = threadIdx.x; asm volatile("" : "+v"(tid_)); const int tid = tid_, wid = __builtin_amdgcn_readfirstlane(tid >> 6), lane = tid & 63, wr = wid >> 2, wc = wid & 3, fr = lane & 15, fq = lane >> 4;
    const int K = g.K, nt = K / BK;
    unsigned voffA[2], voffB[2];
#pragma unroll
    for (int i = 0; i < 2; ++i) { int R, C; stage_rc(tid * 16 + i * 8192, R, C); const int Rb = Epi::PERM ? ((R & ~31) + perm32(R & 31)) : R;
        voffA[i] = (unsigned)(R * K + C) * 2u; voffB[i] = (unsigned)(Rb * K + C) * 2u; }
    const size_t kstep = (size_t)(BK * 2);
    const size_t hstep = (size_t)HALF * K * 2;
    const size_t tstep = 2 * hstep;
    const unsigned ldsw = (unsigned)wid * 1024u;
    const int aoff = lds_byte(wr * 64 + fr, fq * 8), boff = lds_byte(wc * 32 + fr, fq * 8);
#define PG8_SA(b, h) (((b) * 2 + (h)) * HTB)
#define PG8_SB(b, h) ((4 + (b) * 2 + (h)) * HTB)
#define PG8_STAGE(bufoff, gbase, voff) do { _Pragma("unroll") for (int _i = 0; _i < 2; ++_i) \
        __builtin_amdgcn_global_load_lds((const unsigned*)((const char*)(gbase) + (voff)[_i]), (PG8_LAS unsigned*)(lds + (bufoff) + ldsw + _i * 8192), 16, 0, 0); } while (0)
#define PG8_LDA(dst, b, h) do { _Pragma("unroll") for (int m = 0; m < 4; ++m) _Pragma("unroll") for (int k = 0; k < 2; ++k) dst[m][k] = *(const PG8_LAS bf16x8*)(lds + PG8_SA(b, h) + aoff + m * 2048 + k * 1024); } while (0)
#define PG8_LDB(dst, b, h) do { _Pragma("unroll") for (int n = 0; n < 2; ++n) _Pragma("unroll") for (int k = 0; k < 2; ++k) dst[n][k] = *(const PG8_LAS bf16x8*)(lds + PG8_SB(b, h) + boff + n * 2048 + k * 1024); } while (0)
#define PG8_MMA(ai, bj, At, Bt) do { __builtin_amdgcn_s_setprio(1); _Pragma("unroll") for (int m = 0; m < 4; ++m) _Pragma("unroll") for (int n = 0; n < 2; ++n) _Pragma("unroll") for (int k = 0; k < 2; ++k) \
        acc[ai][bj][m][n] = __builtin_amdgcn_mfma_f32_16x16x32_bf16(Bt[n][k], At[m][k], acc[ai][bj][m][n], 0, 0, 0); __builtin_amdgcn_s_setprio(0); } while (0)
#define PG8_WAIT_V(n) asm volatile("s_waitcnt vmcnt(" #n ")" ::: "memory")
#define PG8_WAIT_L(n) asm volatile("s_waitcnt lgkmcnt(" #n ")" ::: "memory")
#define PG8_BAR __builtin_amdgcn_s_barrier()
#define PG8_SCHED __builtin_amdgcn_sched_barrier(0)
    Unit cur, nxt; int ui = 0;
    if (!S.next(0, cur)) return;
    f32x4 acc[2][2][4][2];
#pragma unroll
    for (int a = 0; a < 2; ++a)
#pragma unroll
        for (int b = 0; b < 2; ++b)
#pragma unroll
            for (int m = 0; m < 4; ++m)
#pragma unroll
                for (int n = 0; n < 2; ++n) acc[a][b][m][n] = (f32x4){0.f, 0.f, 0.f, 0.f};
    bf16x8 At[4][2], B0[2][2], B1[2][2];
    const char* cA = (const char*)g.A + (size_t)cur.pm * tstep; const char* cB = (const char*)g.Bt + (size_t)cur.pn * tstep;
    S.a_ready(cur);
    PG8_STAGE(PG8_SB(0, 0), cB, voffB); PG8_STAGE(PG8_SA(0, 0), cA, voffA); PG8_STAGE(PG8_SB(0, 1), cB + hstep, voffB); PG8_STAGE(PG8_SA(0, 1), cA + hstep, voffA);
    if (wr == 1) PG8_BAR;
    PG8_WAIT_V(4); PG8_BAR;
    PG8_STAGE(PG8_SB(1, 0), cB + kstep, voffB); PG8_STAGE(PG8_SA(1, 0), cA + kstep, voffA); PG8_STAGE(PG8_SB(1, 1), cB + hstep + kstep, voffB);
    PG8_WAIT_V(6); PG8_BAR;
    for (;;) {
        const bool has_next = S.next(ui + 1, nxt);
        const char* nA = has_next ? (const char*)g.A + (size_t)nxt.pm * tstep : cA; const char* nB = has_next ? (const char*)g.Bt + (size_t)nxt.pn * tstep : cB;
        for (int t = 0; t < nt; t += 2) {
            const bool last = (t == nt - 2);
            const char* a1 = cA + (size_t)(t + 1) * kstep;
            const char* a2 = last ? nA : cA + (size_t)(t + 2) * kstep; const char* b2 = last ? nB : cB + (size_t)(t + 2) * kstep;
            const char* a3 = a2 + kstep; const char* b3 = b2 + kstep;
            if (last && has_next) S.a_ready(nxt);
            PG8_LDB(B0, 0, 0); PG8_SCHED; PG8_LDA(At, 0, 0); PG8_STAGE(PG8_SA(1, 1), a1 + hstep, voffA);
            PG8_WAIT_L(8); PG8_BAR; PG8_WAIT_L(0); PG8_MMA(0, 0, At, B0); PG8_BAR; PG8_SCHED;
            PG8_LDB(B1, 0, 1); PG8_STAGE(PG8_SB(0, 0), b2, voffB);
            PG8_BAR; PG8_WAIT_L(0); PG8_MMA(0, 1, At, B1); PG8_BAR;
            PG8_LDA(At, 0, 1); PG8_STAGE(PG8_SA(0, 0), a2, voffA);
            PG8_BAR; PG8_WAIT_L(0); PG8_MMA(1, 0, At, B0); PG8_BAR; PG8_SCHED;
            PG8_STAGE(PG8_SB(0, 1), b2 + hstep, voffB);
            PG8_WAIT_V(6); PG8_BAR; PG8_MMA(1, 1, At, B1); PG8_BAR;
            PG8_LDB(B0, 1, 0); PG8_SCHED; PG8_LDA(At, 1, 0); PG8_STAGE(PG8_SA(0, 1), a2 + hstep, voffA);
            PG8_WAIT_L(8); PG8_BAR; PG8_WAIT_L(0); PG8_MMA(0, 0, At, B0); PG8_BAR; PG8_SCHED;
            PG8_LDB(B1, 1, 1); PG8_STAGE(PG8_SB(1, 0), b3, voffB);
            PG8_BAR; PG8_WAIT_L(0); PG8_MMA(0, 1, At, B1); PG8_BAR;
            PG8_LDA(At, 1, 1); PG8_STAGE(PG8_SA(1, 0), a3, voffA);
            PG8_BAR; PG8_WAIT_L(0); PG8_MMA(1, 0, At, B0); PG8_BAR; PG8_SCHED;
            PG8_STAGE(PG8_SB(1, 1), b3 + hstep, voffB);
            PG8_WAIT_V(6); PG8_BAR; PG8_MMA(1, 1, At, B1); PG8_BAR;
        }
        if constexpr (!Epi::AFTER_DRAIN) { E(acc, cur, wr, wc, fr, fq); S.done(cur); }
        if (!has_next) break;
#pragma unroll
        for (int a = 0; a < 2; ++a)
#pragma unroll
            for (int b = 0; b < 2; ++b)
#pragma unroll
                for (int m = 0; m < 4; ++m)
#pragma unroll
                    for (int n = 0; n < 2; ++n) acc[a][b][m][n] = (f32x4){0.f, 0.f, 0.f, 0.f};
        cur = nxt; cA = nA; cB = nB; ++ui;
    }
    PG8_WAIT_V(0);
    if (wr == 0) PG8_BAR;
    PG8_BAR;
    if constexpr (Epi::AFTER_DRAIN) { E.fused(acc, cur, wr, wc, fr, fq, lds, wid, lane); S.done(cur); }
#undef PG8_SA
#undef PG8_SB
#undef PG8_STAGE
#undef PG8_LDA
#undef PG8_LDB
#undef PG8_MMA
#undef PG8_WAIT_V
#undef PG8_WAIT_L
#undef PG8_BAR
#undef PG8_SCHED
}
}

#define LAS __attribute__((address_space(3)))
using pg8::bf16_t; using pg8::bf16x8; using pg8::f32x4;
typedef float f32x2 __attribute__((ext_vector_type(2)));
typedef unsigned u32x2 __attribute__((ext_vector_type(2)));
typedef unsigned u32x4v __attribute__((ext_vector_type(4)));

constexpr int D = 1024, DFF = 2816, DIN = 3072, DEPTH = 4;
constexpr int T_CTX = 8192, T_LAT = 32768, T = T_CTX + T_LAT;
constexpr int NCHUNK = T / 128;
constexpr int MODW = 9 * D;
constexpr float ALPHA_F = 1.6817928305074290f;
constexpr float EPS_F = 1e-5f;
constexpr int LDS_WORK = 139264;
constexpr int LDS_BYTES = LDS_WORK + 16;

constexpr size_t WS_X = 0;
constexpr size_t WS_H = WS_X + (size_t)T * D * 2;
constexpr size_t WS_MIX = WS_H + (size_t)T * D * 2;
constexpr size_t WS_U = WS_MIX + (size_t)T * D * 2;
constexpr size_t SZ_T512 = (size_t)T * 512 * 2;
constexpr size_t WS_RPT = WS_U + 6 * SZ_T512;
constexpr size_t WS_WT = WS_RPT + (size_t)2 * NCHUNK * 4 * 16384 * 2;
constexpr size_t WT_W1 = 0, WT_W2 = WT_W1 + (size_t)2 * 5632 * 1024, WT_WIN = WT_W2 + (size_t)2 * 1024 * 2816, WT_WOUT = WT_WIN + (size_t)3072 * 1024, WT_ELEMS = WT_WOUT + (size_t)1024 * 1024;
constexpr size_t WS_MOD = WS_WT + WT_ELEMS * 2;
constexpr size_t WS_ROPE = WS_MOD + (size_t)DEPTH * 9 * MODW * 4;
constexpr size_t WS_SLOT = WS_ROPE + 64 * 32 * 2 * 4;
constexpr size_t WS_CNT = WS_SLOT + (size_t)T * 16 * 8;
constexpr int N_CNT = 12 * 160 * 2;
constexpr size_t WS_BAR = WS_CNT + (size_t)N_CNT * 4;
constexpr size_t WS_END = WS_BAR + 3456 * 4;

constexpr size_t OUT_YS = 0, OUT_SF = (size_t)T * D, OUT_SB = OUT_SF + (size_t)32 * DEPTH * 4 * 16384;

struct Params {
    const float* in[19];
    float* out;
    unsigned char* ws;
    int ph_lo, ph_hi;
};
typedef const __attribute__((address_space(4))) Params* CP;
enum { I_XP = 0, I_XS, I_SF, I_SB, I_C, I_CCTX, I_WADA, I_BADA, I_LNG, I_LNB, I_W1, I_W2, I_WIN, I_WOUT, I_CW, I_CB, I_CLG, I_CLB, I_DEC };

__device__ __forceinline__ unsigned cvt_pk_bf16(float lo, float hi) { unsigned r; asm("v_cvt_pk_bf16_f32 %0, %1, %2" : "=v"(r) : "v"(lo), "v"(hi)); return r; }
__device__ __forceinline__ int my_tid() { int t = threadIdx.x; asm volatile("" : "+v"(t)); return t; }
__device__ __forceinline__ float bf_lo(unsigned u) { return __uint_as_float(u << 16); }
__device__ __forceinline__ float bf_hi(unsigned u) { return __uint_as_float(u & 0xffff0000u); }
__device__ __forceinline__ float fast_sigmoid(float x) { return __builtin_amdgcn_rcpf(1.0f + __expf(-x)); }
__device__ __forceinline__ float fast_silu(float x) { return x * fast_sigmoid(x); }
__device__ __forceinline__ int mod_row_of_tile(int pm) { return pm < 32 ? 0 : 1 + ((pm - 32) >> 4); }
__device__ __forceinline__ int mod_row_of_tok(int t) { return t < T_CTX ? 0 : 1 + ((t - T_CTX) >> 12); }
__device__ __forceinline__ float wave_sum(float v) {
#pragma unroll
    for (int o = 32; o >= 1; o >>= 1) v += __shfl_xor(v, o, 64);
    return v;
}
__device__ __forceinline__ float log_sigmoid_f(float x) { return -log1pf(__expf(-x)); }

struct EpiSwiglu {
    static constexpr bool PERM = true, AFTER_DRAIN = false;
    bf16_t* O;
    __device__ __forceinline__ void operator()(const f32x4 (&acc)[2][2][4][2], const pg8::Unit& u, int wr, int wc, int fr, int fq) const {
        const int row0 = u.pm * 256 + wr * 64 + fr, col0 = u.pn * 128 + wc * 32 + 8 * fq;
#pragma unroll
        for (int ai = 0; ai < 2; ++ai)
#pragma unroll
            for (int m = 0; m < 4; ++m) {
                bf16_t* dst = O + (size_t)(row0 + ai * 128 + m * 16) * DFF + col0;
                const f32x4 a0 = acc[ai][0][m][0], a1 = acc[ai][0][m][1], b0 = acc[ai][1][m][0], b1 = acc[ai][1][m][1];
                u32x4v o;
                o[0] = cvt_pk_bf16(fast_silu(a0[0]) * b0[0], fast_silu(a0[1]) * b0[1]);
                o[1] = cvt_pk_bf16(fast_silu(a0[2]) * b0[2], fast_silu(a0[3]) * b0[3]);
                o[2] = cvt_pk_bf16(fast_silu(a1[0]) * b1[0], fast_silu(a1[1]) * b1[1]);
                o[3] = cvt_pk_bf16(fast_silu(a1[2]) * b1[2], fast_silu(a1[3]) * b1[3]);
                *(u32x4v*)dst = o;
            }
    }
};
struct EpiResid {
    static constexpr bool PERM = false, AFTER_DRAIN = false;
    float* X; const float* gate; float gscale;
    __device__ __forceinline__ void operator()(const f32x4 (&acc)[2][2][4][2], const pg8::Unit& u, int wr, int wc, int fr, int fq) const {
        const int row0 = u.pm * 256 + wr * 64 + fr, col0 = u.pn * 256 + wc * 32 + 4 * fq;
        const float* gp = gate + (size_t)mod_row_of_tile(u.pm) * MODW + col0;
#pragma unroll
        for (int ai = 0; ai < 2; ++ai)
#pragma unroll
            for (int m = 0; m < 4; ++m) {
                float* rowp = X + (size_t)(row0 + ai * 128 + m * 16) * D + col0;
#pragma unroll
                for (int bj = 0; bj < 2; ++bj)
#pragma unroll
                    for (int n = 0; n < 2; ++n) {
                        const f32x4 gv = *(const f32x4*)(gp + bj * 128 + n * 16) * gscale;
                        f32x4 x = *(const f32x4*)(rowp + bj * 128 + n * 16);
                        x = x * ALPHA_F + gv * acc[ai][bj][m][n];
                        *(f32x4*)(rowp + bj * 128 + n * 16) = x;
                    }
            }
    }
};
struct QuadOrder {
    int nM, c;
    __device__ void init(int M, int c_) { nM = M / 256; c = c_; }
    __device__ bool next(int i, pg8::Unit& u) const {
        const int xcd = c & 7, k = c >> 3, full = nM >> 6;
        if (i < full) { u.pm = 64 * i + 8 * xcd + (k >> 2); u.pn = k & 3; return true; }
        if (i == full) { const int per = (nM - 64 * full) >> 3; if ((k >> 2) < per) { u.pm = 64 * full + per * xcd + (k >> 2); u.pn = k & 3; return true; } }
        return false;
    }
    __device__ __forceinline__ void a_ready(const pg8::Unit&) const {}
    __device__ __forceinline__ void done(const pg8::Unit&) const {}
};
typedef _Float16 f16x8 __attribute__((ext_vector_type(8)));
typedef float f32x8 __attribute__((ext_vector_type(8)));
struct EpiResLn {
    static constexpr bool PERM = true, AFTER_DRAIN = false;
    CP p; int l, sub;
    __device__ __forceinline__ void operator()(f32x4 (&acc)[2][2][4][2], const pg8::Unit& u, int wr, int wc, int fr, int fq) const {
        CP pp = p; asm volatile("" : "+s"(pp));
        f16x8* XP = (f16x8*)(pp->ws + WS_X); bf16_t* H = (bf16_t*)(pp->ws + WS_H);
        const bool fin = (l == DEPTH - 1 && sub == 2);
        float* OUT = pp->out;
        const float* MOD = (const float*)(pp->ws + WS_MOD);
        const float* gate = MOD + (size_t)l * 9 * MODW + (size_t)(sub == 1 ? 5 : (sub == 0 ? 2 : 8)) * D;
        const float gscale = sub == 1 ? 1.0f : 0.5f;
        const float* lng = pp->in[I_LNG] + (size_t)(l * 3 + sub) * D; const float* lnb = pp->in[I_LNB] + (size_t)(l * 3 + sub) * D;
        const int nl = sub == 2 ? (l + 1 < DEPTH ? l + 1 : l) : l, ns = sub == 2 ? 0 : sub + 1;
        const float* modn = MOD + (size_t)nl * 9 * MODW + (size_t)(3 * ns) * D;
        char* slots = (char*)(pp->ws + WS_SLOT); unsigned* cnt = (unsigned*)(pp->ws + WS_CNT) + (size_t)(l * 3 + sub) * 320;
        const int lane = fr + 16 * fq;
        const int row0 = u.pm * 256 + wr * 64 + fr, col0 = u.pn * 256 + wc * 32 + 8 * fq;
        const unsigned xp0 = (unsigned)((((u.pm * 4 + u.pn) * 8 + wr * 4 + wc) * 16) * 64 + lane);
        const int mrow = mod_row_of_tile(u.pm);
        const float* gp = gate + (size_t)mrow * MODW + col0;
        float s1[8], s2[8];
#pragma unroll
        for (int i = 0; i < 8; ++i) { s1[i] = 0.f; s2[i] = 0.f; }
        f16x8 xq[16];
#pragma unroll
        for (int gq = 0; gq < 16; ++gq) xq[gq] = XP[xp0 + (unsigned)(gq * 64)];
        __builtin_amdgcn_sched_barrier(0);
#pragma unroll
        for (int bj = 0; bj < 2; ++bj) {
            const f32x4 gv0 = *(const f32x4*)(gp + bj * 128) * gscale, gv1 = *(const f32x4*)(gp + bj * 128 + 4) * gscale;
#pragma unroll
            for (int ai = 0; ai < 2; ++ai)
#pragma unroll
                for (int m = 0; m < 4; ++m) {
                    const f32x8 x = __builtin_convertvector(xq[(ai * 2 + bj) * 4 + m], f32x8);
                    const f32x4 z0 = (f32x4){x[0], x[1], x[2], x[3]} * ALPHA_F + gv0 * acc[ai][bj][m][0];
                    const f32x4 z1 = (f32x4){x[4], x[5], x[6], x[7]} * ALPHA_F + gv1 * acc[ai][bj][m][1];
                    acc[ai][bj][m][0] = z0; acc[ai][bj][m][1] = z1;
                    s1[ai * 4 + m] += ((z0[0] + z0[1]) + (z0[2] + z0[3])) + ((z1[0] + z1[1]) + (z1[2] + z1[3]));
                    s2[ai * 4 + m] += ((z0[0] * z0[0] + z0[1] * z0[1]) + (z0[2] * z0[2] + z0[3] * z0[3])) + ((z1[0] * z1[0] + z1[1] * z1[1]) + (z1[2] * z1[2] + z1[3] * z1[3]));
                }
        }
#pragma unroll
        for (int i = 0; i < 8; ++i) { s1[i] += __shfl_xor(s1[i], 16, 64); s2[i] += __shfl_xor(s2[i], 16, 64); }
#pragma unroll
        for (int i = 0; i < 8; ++i) { s1[i] += __shfl_xor(s1[i], 32, 64); s2[i] += __shfl_xor(s2[i], 32, 64); }
        const unsigned so0 = (unsigned)(row0 * 64);
#pragma unroll
        for (int i = 0; i < 8; ++i) {
            if ((i >> 1) == fq) {
                const unsigned v = (unsigned)__builtin_bit_cast(unsigned short, (_Float16)s1[i]) | ((unsigned)__builtin_bit_cast(unsigned short, (_Float16)s2[i]) << 16);
                __hip_atomic_store((unsigned*)(slots + (so0 + (unsigned)(((i >> 2) * 128 + (i & 3) * 16) * 64) + (unsigned)((u.pn * 4 + wc) * 4))), v, __ATOMIC_RELAXED, __HIP_MEMORY_SCOPE_AGENT);
            }
        }
        asm volatile("s_waitcnt vmcnt(0)" ::: "memory");
        const float* mp = modn + (size_t)mrow * MODW + col0;
        const f32x4 pg0 = *(const f32x4*)(lng + col0), pg1 = *(const f32x4*)(lng + col0 + 4), pb0 = *(const f32x4*)(lnb + col0), pb1 = *(const f32x4*)(lnb + col0 + 4);
        unsigned* cp = cnt + (u.pm * 2 + wr);
        if (lane == 0) __hip_atomic_fetch_add(cp, 1u, __ATOMIC_RELAXED, __HIP_MEMORY_SCOPE_AGENT);
        for (int spins = 0; spins < (1 << 20); ++spins) {
            const unsigned v = __builtin_amdgcn_readfirstlane(__hip_atomic_load(cp, __ATOMIC_RELAXED, __HIP_MEMORY_SCOPE_AGENT));
            if (v >= 16u) break;
            __builtin_amdgcn_s_sleep(2);
        }
        unsigned xp1 = xp0, so1 = so0; asm volatile("" : "+v"(xp1), "+v"(so1));
        float mu[8], rs[8];
        const __amdgpu_buffer_rsrc_t srs = __builtin_amdgcn_make_buffer_rsrc((void*)slots, (short)0, (int)(T * 64), 0x00020000);
        {
            u32x4v sv[8];
#pragma unroll
            for (int i = 0; i < 8; ++i) sv[i] = __builtin_amdgcn_raw_buffer_load_b128(srs, so1 + (unsigned)(((i >> 2) * 128 + (i & 3) * 16) * 64) + (unsigned)(16 * fq), 0, 16);
            __builtin_amdgcn_sched_barrier(0);
            float sa[8], sb[8];
#pragma unroll
            for (int i = 0; i < 8; ++i) {
                float a = 0.f, b = 0.f;
#pragma unroll
                for (int q = 0; q < 4; ++q) { a += (float)__builtin_bit_cast(_Float16, (unsigned short)(sv[i][q] & 0xffffu)); b += (float)__builtin_bit_cast(_Float16, (unsigned short)(sv[i][q] >> 16)); }
                sa[i] = a; sb[i] = b;
            }
#pragma unroll
            for (int i = 0; i < 8; ++i) { sa[i] += __shfl_xor(sa[i], 16, 64); sb[i] += __shfl_xor(sb[i], 16, 64); }
#pragma unroll
            for (int i = 0; i < 8; ++i) { sa[i] += __shfl_xor(sa[i], 32, 64); sb[i] += __shfl_xor(sb[i], 32, 64); }
#pragma unroll
            for (int i = 0; i < 8; ++i) {
                const float m_ = sa[i] * (1.0f / D);
                mu[i] = m_; rs[i] = rsqrtf(fmaxf(sb[i] * (1.0f / D) - m_ * m_, 0.f) + EPS_F);
            }
        }
        const unsigned ro0 = (unsigned)(row0 * D + col0);
#pragma unroll
        for (int bj = 0; bj < 2; ++bj) {
            const int co = bj * 128;
            const f32x4 g0 = bj ? *(const f32x4*)(lng + col0 + co) : pg0, g1 = bj ? *(const f32x4*)(lng + col0 + co + 4) : pg1, b0 = bj ? *(const f32x4*)(lnb + col0 + co) : pb0, b1 = bj ? *(const f32x4*)(lnb + col0 + co + 4) : pb1;
            const f32x4 sh0 = *(const f32x4*)(mp + co), sh1 = *(const f32x4*)(mp + co + 4), sc0 = *(const f32x4*)(mp + D + co) + 1.0f, sc1 = *(const f32x4*)(mp + D + co + 4) + 1.0f;
#pragma unroll
            for (int ai = 0; ai < 2; ++ai)
#pragma unroll
                for (int m = 0; m < 4; ++m) {
                    const f32x4 x0 = (acc[ai][bj][m][0] - mu[ai * 4 + m]) * rs[ai * 4 + m] * g0 + b0, x1 = (acc[ai][bj][m][1] - mu[ai * 4 + m]) * rs[ai * 4 + m] * g1 + b1;
                    const unsigned ro = ro0 + (unsigned)((ai * 128 + m * 16) * D + co);
                    if (fin) { *(f32x4*)(OUT + ro) = x0; *(f32x4*)(OUT + ro + 4) = x1; }
                    else {
                        const f32x8 xv = (f32x8){x0[0], x0[1], x0[2], x0[3], x1[0], x1[1], x1[2], x1[3]};
                        XP[xp1 + (unsigned)(((ai * 2 + bj) * 4 + m) * 64)] = __builtin_convertvector(xv, f16x8);
                        const f32x4 h0 = x0 * sc0 + sh0, h1 = x1 * sc1 + sh1;
                        u32x4v o; o[0] = cvt_pk_bf16(h0[0], h0[1]); o[1] = cvt_pk_bf16(h0[2], h0[3]); o[2] = cvt_pk_bf16(h1[0], h1[1]); o[3] = cvt_pk_bf16(h1[2], h1[3]);
                        *(u32x4v*)(H + ro) = o;
                    }
                }
            __builtin_amdgcn_sched_barrier(0);
        }
    }
};
struct EpiMixIn {
    static constexpr bool PERM = true, AFTER_DRAIN = false;
    bf16_t *UPRE, *Q, *K, *KT, *VT, *SG; const float* rope;
    __device__ __forceinline__ void operator()(const f32x4 (&acc)[2][2][4][2], const pg8::Unit& u, int wr, int wc, int fr, int fq) const {
        const int row0 = u.pm * 256 + wr * 64 + fr;
        const int pn = u.pn;
        if (pn < 4) {
            const int col0 = pn * 128 + wc * 32 + 8 * fq;
#pragma unroll
            for (int ai = 0; ai < 2; ++ai)
#pragma unroll
                for (int m = 0; m < 4; ++m) {
                    const f32x4 a0 = acc[ai][0][m][0], a1 = acc[ai][0][m][1], b0 = acc[ai][1][m][0], b1 = acc[ai][1][m][1];
                    u32x4v o;
                    o[0] = cvt_pk_bf16(a0[0] * fast_sigmoid(b0[0]), a0[1] * fast_sigmoid(b0[1]));
                    o[1] = cvt_pk_bf16(a0[2] * fast_sigmoid(b0[2]), a0[3] * fast_sigmoid(b0[3]));
                    o[2] = cvt_pk_bf16(a1[0] * fast_sigmoid(b1[0]), a1[1] * fast_sigmoid(b1[1]));
                    o[3] = cvt_pk_bf16(a1[2] * fast_sigmoid(b1[2]), a1[3] * fast_sigmoid(b1[3]));
                    *(u32x4v*)(UPRE + (size_t)(row0 + ai * 128 + m * 16) * 512 + col0) = o;
                }
        } else if (pn < 8) {
            const bool isk = pn >= 6, lat = u.pm >= 32;
            const int head = 2 * (pn & 1) + (wc >> 1), colrot = wc & 1, dbase = 64 * colrot + 8 * fq;
            const float sc = isk ? 1.0f : 0.08838834764831845f;
            bf16_t* RM = isk ? K : Q;
#pragma unroll
            for (int ai = 0; ai < 2; ++ai)
#pragma unroll
                for (int m = 0; m < 4; ++m) {
                    const int row = row0 + ai * 128 + m * 16;
                    const int sp = (row - T_CTX) & 4095, pos = colrot ? (sp & 63) : (sp >> 6);
                    const float* rp = rope + (size_t)(pos * 32 + 8 * fq) * 2;
                    bf16_t* dst = RM + (size_t)row * 512 + head * 128 + dbase;
                    const int chunk = row >> 7, c = row & 127;
                    bf16_t* kt = KT + ((size_t)(chunk * 4 + head) * 128 + dbase) * 128 + c;
#pragma unroll
                    for (int n = 0; n < 2; ++n) {
                        const f32x4 x1 = acc[ai][0][m][n], x2 = acc[ai][1][m][n];
                        f32x4 o1, o2;
                        if (lat) {
                            const f32x4 csa = *(const f32x4*)(rp + 8 * n), csb = *(const f32x4*)(rp + 8 * n + 4);
                            o1[0] = x1[0] * csa[0] - x2[0] * csa[1]; o2[0] = x1[0] * csa[1] + x2[0] * csa[0];
                            o1[1] = x1[1] * csa[2] - x2[1] * csa[3]; o2[1] = x1[1] * csa[3] + x2[1] * csa[2];
                            o1[2] = x1[2] * csb[0] - x2[2] * csb[1]; o2[2] = x1[2] * csb[1] + x2[2] * csb[0];
                            o1[3] = x1[3] * csb[2] - x2[3] * csb[3]; o2[3] = x1[3] * csb[3] + x2[3] * csb[2];
                        } else { o1 = x1; o2 = x2; }
                        o1 *= sc; o2 *= sc;
                        u32x2 p1, p2;
                        p1[0] = cvt_pk_bf16(o1[0], o1[1]); p1[1] = cvt_pk_bf16(o1[2], o1[3]);
                        p2[0] = cvt_pk_bf16(o2[0], o2[1]); p2[1] = cvt_pk_bf16(o2[2], o2[3]);
                        *(u32x2*)(dst + 4 * n) = p1; *(u32x2*)(dst + 32 + 4 * n) = p2;
                        if (isk) {
#pragma unroll
                            for (int q = 0; q < 2; ++q) {
                                kt[(size_t)(4 * n + 2 * q) * 128] = (bf16_t)(p1[q] & 0xffffu); kt[(size_t)(4 * n + 2 * q + 1) * 128] = (bf16_t)(p1[q] >> 16);
                                kt[(size_t)(4 * n + 2 * q + 32) * 128] = (bf16_t)(p2[q] & 0xffffu); kt[(size_t)(4 * n + 2 * q + 33) * 128] = (bf16_t)(p2[q] >> 16);
                            }
                        }
                    }
                }
        } else if (pn < 10) {
#pragma unroll
            for (int ai = 0; ai < 2; ++ai)
#pragma unroll
                for (int m = 0; m < 4; ++m) {
                    const int row = row0 + ai * 128 + m * 16, chunk = row >> 7, c = row & 127;
#pragma unroll
                    for (int bj = 0; bj < 2; ++bj) {
                        const int head = 2 * (pn - 8) + bj, d0 = wc * 32 + 8 * fq;
                        bf16_t* vt = VT + ((size_t)(chunk * 4 + head) * 128 + d0) * 128 + c;
#pragma unroll
                        for (int n = 0; n < 2; ++n) {
                            const unsigned pa = cvt_pk_bf16(acc[ai][bj][m][n][0], acc[ai][bj][m][n][1]), pb = cvt_pk_bf16(acc[ai][bj][m][n][2], acc[ai][bj][m][n][3]);
                            vt[(size_t)(4 * n + 0) * 128] = (bf16_t)(pa & 0xffffu); vt[(size_t)(4 * n + 1) * 128] = (bf16_t)(pa >> 16);
                            vt[(size_t)(4 * n + 2) * 128] = (bf16_t)(pb & 0xffffu); vt[(size_t)(4 * n + 3) * 128] = (bf16_t)(pb >> 16);
                        }
                    }
                }
        } else {
            const int col0 = (pn - 10) * 256 + wc * 32 + 8 * fq;
#pragma unroll
            for (int ai = 0; ai < 2; ++ai)
#pragma unroll
                for (int m = 0; m < 4; ++m)
#pragma unroll
                    for (int bj = 0; bj < 2; ++bj) {
                        const f32x4 a0 = acc[ai][bj][m][0], a1 = acc[ai][bj][m][1];
                        u32x4v o;
                        o[0] = cvt_pk_bf16(fast_silu(a0[0]), fast_silu(a0[1])); o[1] = cvt_pk_bf16(fast_silu(a0[2]), fast_silu(a0[3]));
                        o[2] = cvt_pk_bf16(fast_silu(a1[0]), fast_silu(a1[1])); o[3] = cvt_pk_bf16(fast_silu(a1[2]), fast_silu(a1[3]));
                        *(u32x4v*)(SG + (size_t)(row0 + ai * 128 + m * 16) * 512 + col0 + bj * 128) = o;
                    }
        }
    }
};

__device__ __forceinline__ int wt_src_col(int mat, int np) {
    if (mat < 2) { const int t = np >> 8, bj = (np >> 7) & 1, j = np & 127; return bj * DFF + 128 * t + j; }
    if (mat == 4) {
        const int pn = np >> 8, bj = (np >> 7) & 1, j = np & 127;
        if (pn < 4) return bj * 512 + 128 * pn + j;
        if (pn < 8) { const int base = 1024 + 512 * ((pn - 4) >> 1), head = 2 * (pn & 1) + (j >> 6), e = j & 63; return base + head * 128 + (e < 32 ? e : e + 32) + 32 * bj; }
        return np;
    }
    return np;
}
__device__ void convert_weights(CP p, int layer, LAS unsigned char* lds, int start, int stride, int group, int jlo = 0, int jhi = 1 << 30) {
    const int tid = my_tid();
    bf16_t* WT = (bf16_t*)(p->ws + WS_WT);
    constexpr int LSTR = 264;
    const int ntile0 = group == 0 ? 2624 : (group == 1 ? 2272 : (group == 2 ? 352 : (group == 3 ? 1056 : 1568))), ntile = ntile0 < jhi ? ntile0 : jhi;
    const int kr = tid >> 3, n4 = (tid & 7) * 4;
    for (int j = jlo + start; j < ntile; j += 2 * stride) {
        f32x4 v[2][4]; bf16_t* drow[2]; int dKs[2]; bool ok[2];
#pragma unroll
        for (int u = 0; u < 2; ++u) {
            const int jj = j + u * stride; ok[u] = jj < ntile;
            const int jc = ok[u] ? jj : j;
            const int t = group == 0 ? jc : (group == 1 ? (jc < 1760 ? jc : jc + 352) : (group == 2 ? 1760 + jc : (group == 3 ? (jc < 704 ? jc : 1408 + (jc - 704)) : (jc < 704 ? 704 + jc : 1760 + (jc - 704)))));
            int mat, tl;
            if (t < 1408) { mat = t / 704; tl = t % 704; } else if (t < 2112) { mat = 2 + (t - 1408) / 352; tl = (t - 1408) % 352; } else if (t < 2496) { mat = 4; tl = t - 2112; } else { mat = 5; tl = t - 2496; }
            int Ks, Ns; const float* src; bf16_t* dst;
            if (mat < 2) { Ks = 1024; Ns = 5632; src = p->in[I_W1] + (size_t)(layer * 2 + mat) * 1024 * 5632; dst = WT + WT_W1 + (size_t)mat * 5632 * 1024; }
            else if (mat < 4) { Ks = 2816; Ns = 1024; src = p->in[I_W2] + (size_t)(layer * 2 + mat - 2) * 2816 * 1024; dst = WT + WT_W2 + (size_t)(mat - 2) * 1024 * 2816; }
            else if (mat == 4) { Ks = 1024; Ns = 3072; src = p->in[I_WIN] + (size_t)layer * 1024 * 3072; dst = WT + WT_WIN; }
            else { Ks = 1024; Ns = 1024; src = p->in[I_WOUT] + (size_t)layer * 1024 * 1024; dst = WT + WT_WOUT; }
            const int nkt = Ks >> 8, nt = tl / nkt, kt = tl % nkt;
            const int c0 = wt_src_col(mat, nt * 32);
            drow[u] = dst + (size_t)(nt * 32) * Ks + kt * 256; dKs[u] = Ks;
#pragma unroll
            for (int i = 0; i < 4; ++i) v[u][i] = *(const f32x4*)(src + (size_t)(kt * 256 + kr + 64 * i) * Ns + c0 + n4);
        }
#pragma unroll
        for (int u = 0; u < 2; ++u) {
            LAS bf16_t* L = (LAS bf16_t*)lds + u * (32 * LSTR);
#pragma unroll
            for (int i = 0; i < 4; ++i) {
                const unsigned a = cvt_pk_bf16(v[u][i][0], v[u][i][1]), b = cvt_pk_bf16(v[u][i][2], v[u][i][3]);
                const int k = kr + 64 * i;
                L[(n4 + 0) * LSTR + k] = (bf16_t)(a & 0xffffu); L[(n4 + 1) * LSTR + k] = (bf16_t)(a >> 16);
                L[(n4 + 2) * LSTR + k] = (bf16_t)(b & 0xffffu); L[(n4 + 3) * LSTR + k] = (bf16_t)(b >> 16);
            }
        }
        __syncthreads();
#pragma unroll
        for (int u = 0; u < 2; ++u) {
            if (ok[u]) {
                LAS bf16_t* L = (LAS bf16_t*)lds + u * (32 * LSTR);
                const int n = tid >> 4, kc = (tid & 15) * 16;
                const u32x4v r0 = *(const LAS u32x4v*)(L + n * LSTR + kc), r1 = *(const LAS u32x4v*)(L + n * LSTR + kc + 8);
                bf16_t* d = drow[u] + (size_t)n * dKs[u] + kc;
                *(u32x4v*)d = r0; *(u32x4v*)(d + 8) = r1;
            }
        }
        __syncthreads();
    }
}

__device__ void phase_prep(CP p, LAS unsigned char* lds) {
    const int tid = my_tid();
    float* MOD = (float*)(p->ws + WS_MOD);
    if (blockIdx.x == gridDim.x - 1) {
        float* rope = (float*)(p->ws + WS_ROPE);
        for (int e = tid; e < 2048; e += 512) {
            const int pos = e >> 5, f = e & 31;
            const float inv = exp2f(-(float)f * (13.287712379549449f / 32.0f));
            const float x = (float)pos * inv;
            const float r = x - 6.283185307179586f * rintf(x * 0.15915494309189535f);
            rope[2 * e] = cosf(r); rope[2 * e + 1] = sinf(r);
        }
    }
    if (blockIdx.x < 144) {
        LAS float* S = (LAS float*)lds;
        LAS float* R = (LAS float*)(lds + 9 * 1024 * 4);
        for (int i = tid; i < 9 * 1024; i += 512) {
            const int r = i >> 10, k = i & 1023;
            const float c = r == 0 ? p->in[I_CCTX][k] : p->in[I_C][(r - 1) * 1024 + k];
            S[i] = c / (1.0f + __expf(-c));
        }
        __syncthreads();
        for (int task = blockIdx.x; task < 144; task += gridDim.x) {
            const int l = task / 36, j0 = (task % 36) * 256;
            const int cq = tid & 63, ks = tid >> 6;
            const float* w = p->in[I_WADA] + ((size_t)l * 1024 + ks * 128) * MODW + j0 + 4 * cq;
            f32x4 acc[9];
#pragma unroll
            for (int r = 0; r < 9; ++r) acc[r] = (f32x4){0.f, 0.f, 0.f, 0.f};
#pragma unroll 4
            for (int k = 0; k < 128; ++k) {
                const f32x4 wv = *(const f32x4*)(w + (size_t)k * MODW);
#pragma unroll
                for (int r = 0; r < 9; ++r) acc[r] += wv * S[r * 1024 + ks * 128 + k];
            }
#pragma unroll
            for (int r = 0; r < 9; ++r) *(LAS f32x4*)(R + (ks * 9 + r) * 256 + 4 * cq) = acc[r];
            __syncthreads();
            for (int i = tid; i < 9 * 256; i += 512) {
                const int r = i >> 8, c = i & 255;
                float s = p->in[I_BADA][(size_t)l * MODW + j0 + c];
#pragma unroll
                for (int q = 0; q < 8; ++q) s += R[(q * 9 + r) * 256 + c];
                MOD[((size_t)l * 9 + r) * MODW + j0 + c] = s;
            }
            __syncthreads();
        }
    }
    {
        const bool nomod = blockIdx.x >= 144; const int split = 6 * 112;
        convert_weights(p, 0, lds, nomod ? (int)blockIdx.x - 144 : (int)blockIdx.x, nomod ? 112 : 144, 3, nomod ? 0 : split, nomod ? split : (1 << 30));
    }
    {
        unsigned* cnt = (unsigned*)(p->ws + WS_CNT);
        for (int i = blockIdx.x * 512 + tid; i < N_CNT; i += gridDim.x * 512) cnt[i] = 0u;
    }
}

__device__ void phase_init(CP p) {
    const int tid = my_tid();
    f16x8* XP = (f16x8*)(p->ws + WS_X); bf16_t* H = (bf16_t*)(p->ws + WS_H);
    const float* MOD = (const float*)(p->ws + WS_MOD);
    for (unsigned pc = blockIdx.x * 512 + tid; pc < (unsigned)(T / 256) * 4 * 8 * 16 * 64; pc += gridDim.x * 512) {
        const int lane = pc & 63, g = (pc >> 6) & 15, w = (pc >> 10) & 7, pn = (pc >> 13) & 3, pm = pc >> 15;
        const int fr = lane & 15, fq = lane >> 4, wr = w >> 2, wc = w & 3, ai = g >> 3, bj = (g >> 2) & 1, m = g & 3;
        const int row = pm * 256 + ai * 128 + wr * 64 + m * 16 + fr, col = pn * 256 + bj * 128 + wc * 32 + 8 * fq;
        const float* src = row < T_CTX ? p->in[I_XP] + (size_t)row * D + col : p->in[I_XS] + (size_t)(row - T_CTX) * D + col;
        const f32x4 x0 = *(const f32x4*)src, x1 = *(const f32x4*)(src + 4);
        const f32x8 xv = (f32x8){x0[0], x0[1], x0[2], x0[3], x1[0], x1[1], x1[2], x1[3]};
        XP[pc] = __builtin_convertvector(xv, f16x8);
        const float* mp = MOD + (size_t)mod_row_of_tok(row) * MODW + col;
        const f32x4 h0 = x0 * (*(const f32x4*)(mp + D) + 1.0f) + *(const f32x4*)mp, h1 = x1 * (*(const f32x4*)(mp + D + 4) + 1.0f) + *(const f32x4*)(mp + 4);
        u32x4v o; o[0] = cvt_pk_bf16(h0[0], h0[1]); o[1] = cvt_pk_bf16(h0[2], h0[3]); o[2] = cvt_pk_bf16(h1[0], h1[1]); o[3] = cvt_pk_bf16(h1[2], h1[3]);
        *(u32x4v*)(H + (size_t)row * D + col) = o;
    }
}

__device__ __forceinline__ bf16x8 scale_frag(bf16x8 f, const float (&s)[8]) {
    u32x4v u = __builtin_bit_cast(u32x4v, f), o;
#pragma unroll
    for (int q = 0; q < 4; ++q) o[q] = cvt_pk_bf16(bf_lo(u[q]) * s[2 * q], bf_hi(u[q]) * s[2 * q + 1]);
    return __builtin_bit_cast(bf16x8, o);
}
struct KvSet { bf16x8 a[4]; bf16x8 b[2][4]; };
__device__ void kv_scan_unit(CP p, int layer, int unit) {
    const int tid = my_tid(), w = tid >> 6, lane = tid & 63, l15 = lane & 15, g = lane >> 4;
    int s, h, dir, sl;
    if (unit < 256) { sl = unit & 3; dir = (unit >> 2) & 1; h = (unit >> 3) & 3; s = 32 + (unit >> 5); }
    else { const int u = unit - 256; sl = u & 3; dir = (u >> 2) & 1; h = (u >> 3) & 3; s = u >> 5; }
    const bool lat = s >= 32;
    const int nch = lat ? 32 : 2, chunk0 = lat ? 64 + 32 * (s - 32) : 2 * s;
    const bf16_t* KT = (const bf16_t*)(p->ws + WS_U + 3 * SZ_T512); const bf16_t* VT = (const bf16_t*)(p->ws + WS_U + 4 * SZ_T512);
    bf16_t* RPT = (bf16_t*)(p->ws + WS_RPT);
    const float lg = log_sigmoid_f(p->in[I_DEC][(layer * 2 + dir) * 4 + h]);
    const float cd = __expf(lg * 128.0f);
    float kj[8], kb[4];
#pragma unroll
    for (int j = 0; j < 8; ++j) kj[j] = __expf(lg * (float)(dir == 0 ? -j : j));
#pragma unroll
    for (int kk = 0; kk < 4; ++kk) kb[kk] = __expf(lg * (float)(dir == 0 ? 127 - 32 * kk - 8 * g : 32 * kk + 8 * g));
    const int dk0 = 16 * w + 4 * g;
    f32x4 acc[2];
#pragma unroll
    for (int nb = 0; nb < 2; ++nb) {
        if (lat) {
            const float* r0 = p->in[dir == 0 ? I_SF : I_SB] + ((size_t)((s - 32) * DEPTH + layer) * 4 + h) * 16384;
            const int dv = 32 * sl + 16 * nb + l15;
#pragma unroll
            for (int i = 0; i < 4; ++i) acc[nb][i] = r0[(size_t)(dk0 + i) * 128 + dv];
        } else acc[nb] = (f32x4){0.f, 0.f, 0.f, 0.f};
    }
    const bf16_t* kbase = KT + ((size_t)h * 128 + 16 * w + l15) * 128 + 8 * g;
    const bf16_t* vbase = VT + ((size_t)h * 128 + 32 * sl + l15) * 128 + 8 * g;
    auto chunk_of = [&](int i) { return chunk0 + (dir == 0 ? i : nch - 1 - i); };
    auto load_set = [&](KvSet& S, int i) {
        const size_t co = (size_t)chunk_of(i) * 4 * 16384;
#pragma unroll
        for (int kk = 0; kk < 4; ++kk) {
            S.a[kk] = *(const bf16x8*)(kbase + co + 32 * kk);
            S.b[0][kk] = *(const bf16x8*)(vbase + co + 32 * kk);
            S.b[1][kk] = *(const bf16x8*)(vbase + co + 16 * 128 + 32 * kk);
        }
    };
    auto step = [&](const KvSet& S, int i) {
        const int chunk = chunk_of(i);
#pragma unroll
        for (int nb = 0; nb < 2; ++nb) {
            const int dv = 32 * sl + 16 * nb + l15;
            u32x2 o; o[0] = cvt_pk_bf16(acc[nb][0], acc[nb][1]); o[1] = cvt_pk_bf16(acc[nb][2], acc[nb][3]);
            *(u32x2*)(RPT + (((size_t)(dir * NCHUNK + chunk) * 4 + h) * 128 + dv) * 128 + dk0) = o;
            acc[nb] *= cd;
        }
#pragma unroll
        for (int kk = 0; kk < 4; ++kk) {
            float sc[8];
#pragma unroll
            for (int j = 0; j < 8; ++j) sc[j] = kb[kk] * kj[j];
            const bf16x8 ak = scale_frag(S.a[kk], sc);
#pragma unroll
            for (int nb = 0; nb < 2; ++nb) acc[nb] = __builtin_amdgcn_mfma_f32_16x16x32_bf16(ak, S.b[nb][kk], acc[nb], 0, 0, 0);
        }
    };
    KvSet s0, s1, s2;
    load_set(s0, 0); load_set(s1, 1);
    for (int i = 0; i < nch; i += 3) {
        if (i + 2 < nch) load_set(s2, i + 2);
        step(s0, i);
        if (i + 1 < nch) { if (i + 3 < nch) load_set(s0, i + 3); step(s1, i + 1); }
        if (i + 2 < nch) { if (i + 4 < nch) load_set(s1, i + 4); step(s2, i + 2); }
    }
    if (!lat) {
        float* o = p->out + (dir == 0 ? OUT_SF : OUT_SB) + ((size_t)(s * DEPTH + layer) * 4 + h) * 16384;
#pragma unroll
        for (int nb = 0; nb < 2; ++nb) {
            const int dv = 32 * sl + 16 * nb + l15;
#pragma unroll
            for (int i = 0; i < 4; ++i) o[(size_t)(dk0 + i) * 128 + dv] = acc[nb][i];
        }
    }
}
__device__ void conv_units(CP p, int layer, LAS unsigned char* lds) {
    const int tid = my_tid(), lane = tid & 63, w = tid >> 6;
    const bf16_t* UPRE = (const bf16_t*)(p->ws + WS_U);
    bf16_t* MIX = (bf16_t*)(p->ws + WS_MIX);
    LAS unsigned char* lin = lds; LAS unsigned char* lout = lds + 62 * 1024;
    const int cp = tid & 255, th = tid >> 8;
    const float* cw = p->in[I_CW] + (size_t)layer * 31 * 512 + 2 * cp;
    f32x2 wgt[31];
#pragma unroll
    for (int j = 0; j < 31; ++j) wgt[j] = *(const f32x2*)(cw + (size_t)j * 512);
    const f32x2 bias = *(const f32x2*)(p->in[I_CB] + (size_t)layer * 512 + 2 * cp);
    const float* lg = p->in[I_CLG] + (size_t)layer * 512; const float* lb = p->in[I_CLB] + (size_t)layer * 512;
    const f32x4 g0 = *(const f32x4*)(lg + 4 * lane), g1 = *(const f32x4*)(lg + 256 + 4 * lane), b0 = *(const f32x4*)(lb + 4 * lane), b1 = *(const f32x4*)(lb + 256 + 4 * lane);
    u32x4v pre[8];
    auto issue = [&](int cu) {
        const int tok0 = cu * 32;
        int seg0, seg1;
        if (tok0 < T_CTX) { seg0 = tok0 & ~255; seg1 = seg0 + 256; } else { seg0 = tok0 & ~63; seg1 = seg0 + 64; }
#pragma unroll
        for (int k = 0; k < 8; ++k) {
            const int idx = tid + 512 * k, row = idx >> 6, ch = idx & 63, gr = tok0 - 15 + row;
            u32x4v v = (u32x4v){0u, 0u, 0u, 0u};
            if (idx < 62 * 64 && gr >= seg0 && gr < seg1) v = *(const u32x4v*)(UPRE + (size_t)gr * 512 + ch * 8);
            pre[k] = v;
        }
    };
    int cu = blockIdx.x;
    if (cu < 1280) issue(cu);
    for (; cu < 1280; cu += gridDim.x) {
        const int tok0 = cu * 32;
#pragma unroll
        for (int k = 0; k < 8; ++k) { const int idx = tid + 512 * k; if (idx < 62 * 64) *(LAS u32x4v*)(lin + (idx >> 6) * 1024 + (idx & 63) * 16) = pre[k]; }
        __syncthreads();
        if (cu + (int)gridDim.x < 1280) issue(cu + gridDim.x);
        f32x2 o[16];
#pragma unroll
        for (int t = 0; t < 16; ++t) o[t] = bias;
#pragma unroll
        for (int s = 0; s < 46; ++s) {
            const unsigned u = *(const LAS unsigned*)(lin + (16 * th + s) * 1024 + cp * 4);
            const f32x2 x = (f32x2){bf_lo(u), bf_hi(u)};
#pragma unroll
            for (int t = 0; t < 16; ++t) { if (s - t >= 0 && s - t <= 30) o[t] += wgt[s - t] * x; }
        }
#pragma unroll
        for (int t = 0; t < 16; ++t) *(LAS f32x2*)(lout + (16 * th + t) * 2048 + cp * 8) = o[t];
        __syncthreads();
#pragma unroll 2
        for (int tt = 0; tt < 4; ++tt) {
            const int t = 4 * w + tt;
            f32x4 v0 = *(const LAS f32x4*)(lout + t * 2048 + lane * 16), v1 = *(const LAS f32x4*)(lout + t * 2048 + 1024 + lane * 16);
            const float mu = wave_sum(v0[0] + v0[1] + v0[2] + v0[3] + v1[0] + v1[1] + v1[2] + v1[3]) * (1.0f / 512.0f);
            v0 -= mu; v1 -= mu;
            const float var = wave_sum(v0[0] * v0[0] + v0[1] * v0[1] + v0[2] * v0[2] + v0[3] * v0[3] + v1[0] * v1[0] + v1[1] * v1[1] + v1[2] * v1[2] + v1[3] * v1[3]) * (1.0f / 512.0f);
            const float rstd = rsqrtf(var + EPS_F);
            v0 = v0 * rstd * g0 + b0; v1 = v1 * rstd * g1 + b1;
            u32x2 q0, q1;
            q0[0] = cvt_pk_bf16(fast_silu(v0[0]), fast_silu(v0[1])); q0[1] = cvt_pk_bf16(fast_silu(v0[2]), fast_silu(v0[3]));
            q1[0] = cvt_pk_bf16(fast_silu(v1[0]), fast_silu(v1[1])); q1[1] = cvt_pk_bf16(fast_silu(v1[2]), fast_silu(v1[3]));
            bf16_t* dst = MIX + (size_t)(tok0 + t) * D;
            *(u32x2*)(dst + 4 * lane) = q0; *(u32x2*)(dst + 256 + 4 * lane) = q1;
        }
    }
    __syncthreads();
}
struct KvStep { int lat, s, h, dir, sl, i, nch, chunk; };
__device__ __forceinline__ KvStep kv_step(int j) {
    KvStep k; int u;
    if (j < 32) { u = blockIdx.x; k.lat = 1; k.i = j; k.nch = 32; k.s = 32 + (u >> 5); }
    else { u = blockIdx.x + 256 * ((j - 32) >> 1); k.lat = 0; k.i = (j - 32) & 1; k.nch = 2; k.s = u >> 5; }
    k.sl = u & 3; k.dir = (u >> 2) & 1; k.h = (u >> 3) & 3;
    const int chunk0 = k.lat ? 64 + 32 * (k.s - 32) : 2 * k.s;
    k.chunk = chunk0 + (k.dir == 0 ? k.i : k.nch - 1 - k.i);
    return k;
}
struct KvRegs { bf16x8 a[4]; u32x4v b; };
__device__ void kv_scan_stream(CP p, int layer, LAS unsigned char* lds) {
    const int tid = my_tid(), w = tid >> 6, lane = tid & 63, l15 = lane & 15, g = lane >> 4;
    const bf16_t* KT = (const bf16_t*)(p->ws + WS_U + 3 * SZ_T512); const bf16_t* VT = (const bf16_t*)(p->ws + WS_U + 4 * SZ_T512);
    bf16_t* RPT = (bf16_t*)(p->ws + WS_RPT);
    constexpr int NSTEP = 40, BRS = 272, BSLOT = 32 * BRS;
    const int dk0 = 16 * w + 4 * g;
    auto issue = [&](KvRegs& S, int j) {
        const KvStep k = kv_step(j);
        const bf16_t* kb = KT + ((size_t)(k.chunk * 4 + k.h) * 128 + 16 * w + l15) * 128 + 8 * g;
#pragma unroll
        for (int kk = 0; kk < 4; ++kk) S.a[kk] = *(const bf16x8*)(kb + 32 * kk);
        S.b = *(const u32x4v*)(VT + ((size_t)(k.chunk * 4 + k.h) * 128 + 32 * k.sl + (tid >> 4)) * 128 + (tid & 15) * 8);
    };
    f32x4 acc[2] = {(f32x4){0.f, 0.f, 0.f, 0.f}, (f32x4){0.f, 0.f, 0.f, 0.f}};
    float cd = 0.f, kj[8], kb4[4];
#pragma unroll
    for (int j = 0; j < 8; ++j) kj[j] = 0.f;
#pragma unroll
    for (int kk = 0; kk < 4; ++kk) kb4[kk] = 0.f;
    auto body = [&](KvRegs& S, int j) {
        const KvStep k = kv_step(j);
        LAS unsigned char* slot = lds + (j & 1) * BSLOT;
        *(LAS u32x4v*)(slot + (tid >> 4) * BRS + (tid & 15) * 16) = S.b;
        __syncthreads();
        if (k.i == 0) {
            const float lg = log_sigmoid_f(p->in[I_DEC][(layer * 2 + k.dir) * 4 + k.h]);
            cd = __expf(lg * 128.0f);
#pragma unroll
            for (int jj = 0; jj < 8; ++jj) kj[jj] = __expf(lg * (float)(k.dir == 0 ? -jj : jj));
#pragma unroll
            for (int kk = 0; kk < 4; ++kk) kb4[kk] = __expf(lg * (float)(k.dir == 0 ? 127 - 32 * kk - 8 * g : 32 * kk + 8 * g));
#pragma unroll
            for (int nb = 0; nb < 2; ++nb) {
                if (k.lat) {
                    const float* r0 = p->in[k.dir == 0 ? I_SF : I_SB] + ((size_t)((k.s - 32) * DEPTH + layer) * 4 + k.h) * 16384;
                    const int dv = 32 * k.sl + 16 * nb + l15;
#pragma unroll
                    for (int i = 0; i < 4; ++i) acc[nb][i] = r0[(size_t)(dk0 + i) * 128 + dv];
                } else acc[nb] = (f32x4){0.f, 0.f, 0.f, 0.f};
            }
        }
#pragma unroll
        for (int nb = 0; nb < 2; ++nb) {
            const int dv = 32 * k.sl + 16 * nb + l15;
            u32x2 o; o[0] = cvt_pk_bf16(acc[nb][0], acc[nb][1]); o[1] = cvt_pk_bf16(acc[nb][2], acc[nb][3]);
            *(u32x2*)(RPT + (((size_t)(k.dir * NCHUNK + k.chunk) * 4 + k.h) * 128 + dv) * 128 + dk0) = o;
            acc[nb] *= cd;
        }
#pragma unroll
        for (int kk = 0; kk < 4; ++kk) {
            float sc[8];
#pragma unroll
            for (int jj = 0; jj < 8; ++jj) sc[jj] = kb4[kk] * kj[jj];
            const bf16x8 ak = scale_frag(S.a[kk], sc);
#pragma unroll
            for (int nb = 0; nb < 2; ++nb) {
                const bf16x8 bfr = *(const LAS bf16x8*)(slot + (16 * nb + l15) * BRS + (32 * kk + 8 * g) * 2);
                acc[nb] = __builtin_amdgcn_mfma_f32_16x16x32_bf16(ak, bfr, acc[nb], 0, 0, 0);
            }
        }
        if (!k.lat && k.i == k.nch - 1) {
            float* o = p->out + (k.dir == 0 ? OUT_SF : OUT_SB) + ((size_t)(k.s * DEPTH + layer) * 4 + k.h) * 16384;
#pragma unroll
            for (int nb = 0; nb < 2; ++nb) {
                const int dv = 32 * k.sl + 16 * nb + l15;
#pragma unroll
                for (int i = 0; i < 4; ++i) o[(size_t)(dk0 + i) * 128 + dv] = acc[nb][i];
            }
        }
        if (j + 5 < NSTEP) issue(S, j + 5);
    };
    KvRegs s0, s1, s2, s3, s4;
    issue(s0, 0); issue(s1, 1); issue(s2, 2); issue(s3, 3); issue(s4, 4);
    for (int j = 0; j < NSTEP; j += 5) { body(s0, j); body(s1, j + 1); body(s2, j + 2); body(s3, j + 3); body(s4, j + 4); }
    __syncthreads();
}
__device__ void phase_mix2(CP p, int layer, LAS unsigned char* lds) {
    kv_scan_stream(p, layer, lds);
    conv_units(p, layer, lds);
}

__device__ void phase_mix3(CP p, int layer, LAS unsigned char* lds) {
    const int tid = my_tid(), w = tid >> 6, lane = tid & 63, l15 = lane & 15, g = lane >> 4;
    const bf16_t* Q = (const bf16_t*)(p->ws + WS_U + 1 * SZ_T512); const bf16_t* K = (const bf16_t*)(p->ws + WS_U + 2 * SZ_T512);
    const bf16_t* VT = (const bf16_t*)(p->ws + WS_U + 4 * SZ_T512); const bf16_t* SG = (const bf16_t*)(p->ws + WS_U + 5 * SZ_T512);
    const bf16_t* RPT = (const bf16_t*)(p->ws + WS_RPT);
    bf16_t* MIX = (bf16_t*)(p->ws + WS_MIX);
    constexpr int RS = 272, BUF = 128 * RS;
    LAS unsigned char* Ks = lds; LAS unsigned char* VTs = lds + BUF; LAS unsigned char* RfT = lds + 2 * BUF; LAS unsigned char* RbT = lds + 3 * BUF;
    u32x4v pre[16]; bf16x8 qpre[4];
    auto issue = [&](int pt) {
        const int chunk = pt >> 2, h = pt & 3, tok0 = chunk * 128;
#pragma unroll
        for (int i = 0; i < 4; ++i) {
            const int idx = tid + 512 * i, row = idx >> 4, ch = idx & 15;
            pre[4 * i + 0] = *(const u32x4v*)(K + (size_t)(tok0 + row) * 512 + h * 128 + ch * 8);
            pre[4 * i + 1] = *(const u32x4v*)(VT + ((size_t)(chunk * 4 + h) * 128 + row) * 128 + ch * 8);
            pre[4 * i + 2] = *(const u32x4v*)(RPT + (((size_t)chunk * 4 + h) * 128 + row) * 128 + ch * 8);
            pre[4 * i + 3] = *(const u32x4v*)(RPT + (((size_t)(NCHUNK + chunk) * 4 + h) * 128 + row) * 128 + ch * 8);
        }
#pragma unroll
        for (int kk = 0; kk < 4; ++kk) qpre[kk] = *(const bf16x8*)(Q + (size_t)(tok0 + 16 * w + l15) * 512 + h * 128 + 32 * kk + 8 * g);
    };
    if ((int)blockIdx.x < NCHUNK * 4) issue(blockIdx.x);
    for (int pt = blockIdx.x; pt < NCHUNK * 4; pt += gridDim.x) {
        const int chunk = pt >> 2, h = pt & 3, tok0 = chunk * 128;
#pragma unroll
        for (int i = 0; i < 4; ++i) {
            const int idx = tid + 512 * i, row = idx >> 4, ch = idx & 15;
            *(LAS u32x4v*)(Ks + row * RS + ch * 16) = pre[4 * i + 0]; *(LAS u32x4v*)(VTs + row * RS + ch * 16) = pre[4 * i + 1];
            *(LAS u32x4v*)(RfT + row * RS + ch * 16) = pre[4 * i + 2]; *(LAS u32x4v*)(RbT + row * RS + ch * 16) = pre[4 * i + 3];
        }
        int c = 16 * w + l15;
        asm volatile("" : "+v"(c));
        bf16x8 qf[4], qff[4], qfb[4];
        const float lgf = log_sigmoid_f(p->in[I_DEC][(layer * 2 + 0) * 4 + h]), lgb = log_sigmoid_f(p->in[I_DEC][(layer * 2 + 1) * 4 + h]);
        const float lf2 = lgf * 1.4426950408889634f, lb2 = lgb * 1.4426950408889634f;
#pragma unroll
        for (int kk = 0; kk < 4; ++kk) qf[kk] = qpre[kk];
        __syncthreads();
        if (pt + (int)gridDim.x < NCHUNK * 4) issue(pt + gridDim.x);
        u32x2 sgv[8];
        {
            const bf16_t* sgq = SG + (size_t)(tok0 + c) * 512 + h * 128 + 4 * g;
#pragma unroll
            for (int mb = 0; mb < 8; ++mb) sgv[mb] = *(const u32x2*)(sgq + 16 * mb);
        }
        u32x4v pf[4];
#pragma unroll
        for (int t = 0; t < 8; ++t) {
            f32x4 sacc = (f32x4){0.f, 0.f, 0.f, 0.f};
#pragma unroll
            for (int kk = 0; kk < 4; ++kk) {
                const bf16x8 a = *(const LAS bf16x8*)(Ks + (16 * t + l15) * RS + (32 * kk + 8 * g) * 2);
                sacc = __builtin_amdgcn_mfma_f32_16x16x32_bf16(a, qf[kk], sacc, 0, 0, 0);
            }
#pragma unroll
            for (int i = 0; i < 4; ++i) {
                const float dist = (float)(c - (16 * t + 4 * g + i));
                const float df = __builtin_amdgcn_exp2f(fmaf(lf2, dist, -1000.0f * fmaxf(-dist, 0.f))), db = __builtin_amdgcn_exp2f(fmaf(-lb2, dist, -1000.0f * fmaxf(dist, 0.f)));
                sacc[i] *= (df + db);
            }
            pf[t >> 1][2 * (t & 1)] = cvt_pk_bf16(sacc[0], sacc[1]); pf[t >> 1][2 * (t & 1) + 1] = cvt_pk_bf16(sacc[2], sacc[3]);
            if (t & 1) __builtin_amdgcn_sched_barrier(0);
        }
        f32x4 o[8];
#pragma unroll
        for (int mb = 0; mb < 8; ++mb) o[mb] = (f32x4){0.f, 0.f, 0.f, 0.f};
#pragma unroll
        for (int s = 0; s < 4; ++s) {
            const bf16x8 pb = __builtin_bit_cast(bf16x8, pf[s]);
#pragma unroll
            for (int mb = 0; mb < 8; ++mb) {
                const u32x2 lo = *(const LAS u32x2*)(VTs + (16 * mb + l15) * RS + (32 * s + 4 * g) * 2), hi = *(const LAS u32x2*)(VTs + (16 * mb + l15) * RS + (32 * s + 16 + 4 * g) * 2);
                const u32x4v av = (u32x4v){lo[0], lo[1], hi[0], hi[1]};
                o[mb] = __builtin_amdgcn_mfma_f32_16x16x32_bf16(__builtin_bit_cast(bf16x8, av), pb, o[mb], 0, 0, 0);
            }
            __builtin_amdgcn_sched_barrier(0);
        }
        __builtin_amdgcn_sched_barrier(0);
        {
            const float df = __expf(lgf * (float)(c + 1)), db = __expf(lgb * (float)(128 - c));
            float sf[8], sb[8];
#pragma unroll
            for (int j = 0; j < 8; ++j) { sf[j] = df; sb[j] = db; }
#pragma unroll
            for (int kk = 0; kk < 4; ++kk) { qff[kk] = scale_frag(qf[kk], sf); qfb[kk] = scale_frag(qf[kk], sb); }
        }
#pragma unroll
        for (int kk = 0; kk < 4; ++kk)
#pragma unroll
            for (int mb = 0; mb < 8; ++mb) {
                const bf16x8 af = *(const LAS bf16x8*)(RfT + (16 * mb + l15) * RS + (32 * kk + 8 * g) * 2);
                o[mb] = __builtin_amdgcn_mfma_f32_16x16x32_bf16(af, qff[kk], o[mb], 0, 0, 0);
                const bf16x8 ab = *(const LAS bf16x8*)(RbT + (16 * mb + l15) * RS + (32 * kk + 8 * g) * 2);
                o[mb] = __builtin_amdgcn_mfma_f32_16x16x32_bf16(ab, qfb[kk], o[mb], 0, 0, 0);
                if (mb == 3 || mb == 7) __builtin_amdgcn_sched_barrier(0);
            }
        float s1 = 0.f;
#pragma unroll
        for (int mb = 0; mb < 8; ++mb) s1 += o[mb][0] + o[mb][1] + o[mb][2] + o[mb][3];
        s1 += __shfl_xor(s1, 16, 64); s1 += __shfl_xor(s1, 32, 64);
        const float mu = s1 * (1.0f / 128.0f);
        float s2 = 0.f;
#pragma unroll
        for (int mb = 0; mb < 8; ++mb) { o[mb] -= mu; s2 += o[mb][0] * o[mb][0] + o[mb][1] * o[mb][1] + o[mb][2] * o[mb][2] + o[mb][3] * o[mb][3]; }
        s2 += __shfl_xor(s2, 16, 64); s2 += __shfl_xor(s2, 32, 64);
        const float rstd = rsqrtf(s2 * (1.0f / 128.0f) + EPS_F);
        bf16_t* dst = MIX + (size_t)(tok0 + c) * D + 512 + h * 128 + 4 * g;
#pragma unroll
        for (int mb = 0; mb < 8; ++mb) {
            const u32x2 sg = sgv[mb];
            u32x2 r;
            r[0] = cvt_pk_bf16(o[mb][0] * rstd * bf_lo(sg[0]), o[mb][1] * rstd * bf_hi(sg[0]));
            r[1] = cvt_pk_bf16(o[mb][2] * rstd * bf_lo(sg[1]), o[mb][3] * rstd * bf_hi(sg[1]));
            *(u32x2*)(dst + 16 * mb) = r;
        }
        __syncthreads();
    }
}

#define XB_TMO      128
#define XB_XCNT(j)  (256  + 64 * (j))
#define XB_XSUB(j)  (1280 + 64 * (j))
#define XB_XGEN(j)  (2304 + 64 * (j))
#define XB_TOP      3328
#define XB_TOPGEN   3392
#define XCD_BAR_WORDS 3456
#define XB_SPIN_CAP (1u << 18)

__device__ __forceinline__ unsigned xb_ld(unsigned* p)              { return __hip_atomic_load(p, __ATOMIC_RELAXED, __HIP_MEMORY_SCOPE_AGENT); }
__device__ __forceinline__ unsigned xb_add(unsigned* p, unsigned v) { return __hip_atomic_fetch_add(p, v, __ATOMIC_RELAXED, __HIP_MEMORY_SCOPE_AGENT); }
__device__ __forceinline__ unsigned xb_xcc_id() { return (unsigned)__builtin_amdgcn_s_getreg((3 << 11) | 20) & 0xFu; }
#define XB_SPIN(cond, bar) do { unsigned _sp = 0; while (cond) { __builtin_amdgcn_s_sleep(1); \
    if ((++_sp & 255u) == 0u) { if (xb_ld(&(bar)[XB_TMO])) break; if (_sp > XB_SPIN_CAP) { atomicAdd(&(bar)[XB_TMO], 1u); break; } } } } while (0)
struct XcdBarrier {
    unsigned* bar; unsigned x;
    volatile LAS unsigned* st;
};

__device__ __forceinline__ XcdBarrier xcd_barrier_post(unsigned* bar, volatile LAS unsigned* st) {
    XcdBarrier b; b.bar = bar; b.x = xb_xcc_id(); b.st = st;
    if (threadIdx.x == 0) (void)xb_add(&bar[XB_XCNT(b.x)], 1u);
    return b;
}
__device__ __forceinline__ void xcd_barrier_complete(unsigned* bar, unsigned x, unsigned& nloc, unsigned& nx) {
    const unsigned G = gridDim.x * gridDim.y * gridDim.z;
    unsigned sum, cnt, mine, sp = 0u;
    for (;;) {
        sum = 0u; cnt = 0u; mine = 0u;
#pragma unroll
        for (unsigned j = 0; j < 16; ++j) { const unsigned c = xb_ld(&bar[XB_XCNT(j)]); sum += c; cnt += (c > 0u) ? 1u : 0u; mine = (j == x) ? c : mine; }
        if (sum == G) break;
        __builtin_amdgcn_s_sleep(1);
        if ((++sp & 255u) == 0u) { if (xb_ld(&bar[XB_TMO])) break; if (sp > XB_SPIN_CAP) { atomicAdd(&bar[XB_TMO], 1u); break; } }
    }
    nloc = mine > 0u ? mine : 1u; nx = cnt > 0u ? cnt : 1u;
}

__device__ __forceinline__ void xcd_barrier(const XcdBarrier& b) {
    asm volatile("s_waitcnt vmcnt(0)" ::: "memory");
    __syncthreads();
    if (threadIdx.x == 0) {
        unsigned* bar = b.bar; asm volatile("" : "+s"(bar));
        __builtin_amdgcn_s_waitcnt(0);
        unsigned nloc = b.st[0], nx = b.st[1];
        if (nloc == 0u) { xcd_barrier_complete(bar, b.x, nloc, nx); b.st[0] = nloc; b.st[1] = nx; }
        const unsigned old = xb_add(&bar[XB_XSUB(b.x)], 1u);
        const unsigned gen = old / nloc;
        if (old + 1u == (gen + 1u) * nloc) {
            __builtin_amdgcn_fence(__ATOMIC_RELEASE, "agent");
            asm volatile("s_waitcnt vmcnt(0)" ::: "memory");
            const unsigned og = xb_add(&bar[XB_TOP], 1u);
            const unsigned tg = og / nx;
            if (og + 1u == (tg + 1u) * nx) xb_add(&bar[XB_TOPGEN], 1u);
            else XB_SPIN(xb_ld(&bar[XB_TOPGEN]) == tg, bar);
            __builtin_amdgcn_fence(__ATOMIC_ACQUIRE, "agent");
            xb_add(&bar[XB_XGEN(b.x)], 1u);
            asm volatile("s_waitcnt vmcnt(0)" ::: "memory");
        } else {
            XB_SPIN(xb_ld(&bar[XB_XGEN(b.x)]) == gen, bar);
            __builtin_amdgcn_fence(__ATOMIC_ACQUIRE, "agent");
            asm volatile("s_waitcnt vmcnt(0)" ::: "memory");
        }
    }
    __syncthreads();
}


constexpr int PPL = 8;
constexpr int N_PHASES = 2 + PPL * DEPTH;
#ifndef PHM
#define PHM 0xffff
#endif
__device__ __forceinline__ void run_phase(CP p, int ph, LAS unsigned char* lds, bool dry) {
    bf16_t* WT = (bf16_t*)(p->ws + WS_WT);
    bf16_t* H = (bf16_t*)(p->ws + WS_H); bf16_t* MIX = (bf16_t*)(p->ws + WS_MIX); bf16_t* ACT = (bf16_t*)(p->ws + WS_U);
    const float* MOD = (const float*)(p->ws + WS_MOD);
    if (ph == 0) { if (PHM & 1) phase_prep(p, lds); return; }
    if (ph == 1) { if (PHM & 2) phase_init(p); return; }
    const int l = (ph - 2) / PPL, s = (ph - 2) % PPL;
    if ((PHM & 4) && (s == 0 || s == 6)) {
        pg8::StaticOrder S;
        pg8::Gemm gm{H, WT + WT_W1 + (size_t)(s == 6) * 5632 * 1024, T, 2 * DFF, D};
        S.init(gm.M, gm.N, (int)gridDim.x, (int)blockIdx.x);
        EpiSwiglu E{ACT};
        pg8::gemm_phase<EpiSwiglu, pg8::StaticOrder>(lds, gm, S, E);
    } else if ((PHM & 8) && (s == 1 || s == 7 || s == 5)) {
        const int sub = s == 1 ? 0 : (s == 5 ? 1 : 2);
        const pg8::Gemm gm{s == 5 ? MIX : ACT, s == 5 ? WT + WT_WOUT : WT + WT_W2 + (size_t)(s == 7) * 1024 * 2816, T, D, s == 5 ? D : DFF};
        const EpiResLn E{p, l, sub};
        QuadOrder S; S.init(gm.M, (int)blockIdx.x);
        pg8::gemm_phase<EpiResLn, QuadOrder>(lds, gm, S, E);
        if (s == 7 && l + 1 < DEPTH && (blockIdx.x >> 3) >= 16) convert_weights(p, l + 1, lds, (int)(blockIdx.x & 7) + 8 * ((int)(blockIdx.x >> 3) - 16), 128, 1);
        if (s == 1 && (blockIdx.x >> 3) >= 16) convert_weights(p, l, lds, (int)(blockIdx.x & 7) + 8 * ((int)(blockIdx.x >> 3) - 16), 128, l > 0 ? 2 : 4);
    } else if ((PHM & 16) && s == 2) {
        pg8::StaticOrder S;
        pg8::Gemm gm{H, WT + WT_WIN, T, DIN, D};
        S.init(gm.M, gm.N, (int)gridDim.x, (int)blockIdx.x);
        bf16_t* U = (bf16_t*)(p->ws + WS_U);
        EpiMixIn E{U, U + (size_t)T * 512, U + (size_t)2 * T * 512, U + (size_t)3 * T * 512, U + (size_t)4 * T * 512, U + (size_t)5 * T * 512, (const float*)(p->ws + WS_ROPE)};
        pg8::gemm_phase<EpiMixIn, pg8::StaticOrder>(lds, gm, S, E);
    }
    else if ((PHM & 32) && s == 3) { phase_mix2(p, l, lds); }
    else if ((PHM & 64) && s == 4) { phase_mix3(p, l, lds); }
}

#ifndef DUPM
#define DUPM 0
#endif
__global__ __launch_bounds__(512, 2) void mega_fwd(Params p) {
    extern __shared__ __attribute__((aligned(16))) unsigned char shm[];
    LAS unsigned char* lds = (LAS unsigned char*)shm;
    volatile LAS unsigned* st = (volatile LAS unsigned*)(lds + LDS_WORK);
    if (threadIdx.x < 2) st[threadIdx.x] = 0u;
    __syncthreads();
    const XcdBarrier xb = xcd_barrier_post((unsigned*)(p.ws + WS_BAR), st);
    for (int ph = p.ph_lo; ph < p.ph_hi; ++ph) {
        if (ph > p.ph_lo) {
            if (p.ph_hi < 0) cg::this_grid().sync();
            xcd_barrier(xb);
            if (DUPM & 64) xcd_barrier(xb);
        }
        int nrep = 1;
        if (DUPM) {
            const int s = ph >= 2 ? (ph - 2) % PPL : -1;
            if (((DUPM & 1) && s == 0) || ((DUPM & 2) && s == 2) || ((DUPM & 4) && s == 3) || ((DUPM & 8) && s == 4) || ((DUPM & 32) && ph == 0)) nrep = 2;
        }
        for (int rep = 0; rep < nrep; ++rep) {
            CP pp = (CP)__builtin_amdgcn_kernarg_segment_ptr();
            asm volatile("" : "+s"(pp));
            run_phase(pp, ph, lds, rep + 1 < nrep);
            if (rep + 1 < nrep) __syncthreads();
        }
    }
}

extern "C" void kernel_launch(void* const* d_in, const int* in_sizes, int n_in, void* d_out, int out_size, void* d_ws, size_t ws_size, hipStream_t stream) {
    static int grid = 0;
    if (grid == 0) {
        if (n_in != 19 || ws_size < WS_END) { fprintf(stderr, "kernel_launch: need 19 inputs and >= %zu bytes of workspace; got %d, %zu\n", (size_t)WS_END, n_in, ws_size); grid = -1; return; }
        int dev = 0, cus = 0, per_cu = 0;
        hipGetDevice(&dev);
        hipDeviceGetAttribute(&cus, hipDeviceAttributeMultiprocessorCount, dev);
        if (hipFuncSetAttribute((const void*)mega_fwd, hipFuncAttributeMaxDynamicSharedMemorySize, LDS_BYTES) != hipSuccess) { fprintf(stderr, "kernel_launch: hipFuncSetAttribute failed\n"); grid = -1; return; }
        if (hipOccupancyMaxActiveBlocksPerMultiprocessor(&per_cu, (const void*)mega_fwd, 512, LDS_BYTES) != hipSuccess || per_cu < 1) { fprintf(stderr, "kernel_launch: occupancy query says %d\n", per_cu); per_cu = 1; }
        (void)hipGetLastError();
        grid = cus * 1;
        if (grid != 256) { fprintf(stderr, "kernel_launch: built for 256 CUs, found %d\n", cus); grid = -1; return; }
    }
    if (grid < 0) return;
    (void)hipMemsetAsync((unsigned char*)d_ws + WS_BAR, 0, 3456 * 4, stream);
    Params p{};
    for (int i = 0; i < 19; ++i) p.in[i] = (const float*)d_in[i];
    p.out = (float*)d_out; p.ws = (unsigned char*)d_ws;
#if MK_PER_PHASE
    for (int ph = 0; ph < N_PHASES; ++ph) {
        p.ph_lo = ph; p.ph_hi = ph + 1;
        hipLaunchKernelGGL(mega_fwd, dim3(grid), dim3(512), LDS_BYTES, stream, p);
    }
#else
    p.ph_lo = 0; p.ph_hi = N_PHASES;
    void* args[] = {&p};
    hipError_t e = hipLaunchCooperativeKernel((const void*)mega_fwd, dim3(grid), dim3(512), args, LDS_BYTES, stream);
    if (e != hipSuccess) fprintf(stderr, "cooperative launch failed: %s (grid %d)\n", hipGetErrorString(e), grid);
#endif
}
```

```cpp
#include <hip/hip_runtime.h>
#include <hip/hip_cooperative_groups.h>
#include <cstdio>
namespace cg = cooperative_groups;

#ifndef MK_PER_PHASE
#define MK_PER_PHASE 0
#endif

namespace pg8 {
#define PG8_LAS __attribute__((address_space(3)))
typedef unsigned short bf16_t;
typedef short bf16x8 __attribute__((ext_vector_type(8)));
typedef float f32x4 __attribute__((ext_vector_type(4)));
typedef unsigned u32x4 __attribute__((ext_vector_type(4)));
constexpr int BM = 256, BK = 64, HALF = 128, HTB = HALF * BK * 2, STAGE_BYTES = 8 * HTB, NXCD = 8, WGM = 8;
__host__ __device__ __forceinline__ int lds_byte(int r, int c) { const int st = (r >> 4) * 2 + (c >> 5), rr = r & 15, cc = c & 31, ob = rr * 64 + cc * 2; return st * 1024 + (ob ^ (((ob >> 9) & 1) << 5)); }
__host__ __device__ __forceinline__ void stage_rc(int b, int& R, int& C) { const int st = b / 1024, sb = b % 1024, swz = sb ^ (((sb >> 9) & 1) << 5); R = (st >> 1) * 16 + swz / 64; C = (st & 1) * 32 + (swz % 64) / 2; }
__host__ __device__ __forceinline__ int perm32(int rho) { const int n = rho >> 4, i = rho & 15; return 8 * (i >> 2) + 4 * n + (i & 3); }
struct Unit { int pm, pn; };
struct Gemm { const bf16_t* A; const bf16_t* Bt; int M, N, K; };
struct StaticOrder {
    int nM, nN, nwg, G, c;
    __host__ __device__ void init(int M, int N, int G_, int c_) { nM = M / BM; nN = N / BM; nwg = nM * nN; G = G_; c = c_; }
    __host__ __device__ bool next(int i, Unit& u) const {
        const long L = (long)i * G + c; if (L >= nwg) return false;
        int wgid = (int)L; { const int q = nwg / NXCD, r = nwg % NXCD, xcd = wgid % NXCD, off = wgid / NXCD; wgid = (xcd < r ? xcd * (q + 1) : r * (q + 1) + (xcd - r) * q) + off; }
        const int nig = WGM * nN, gid = wgid / nig, fm = gid * WGM, gsz = (nM - fm) < WGM ? (nM - fm) : WGM;
        u.pm = fm + ((wgid % nig) % gsz); u.pn = (wgid % nig) / gsz; return true;
    }
    __device__ __forceinline__ void a_ready(const Unit&) const {}
    __device__ __forceinline__ void done(const Unit&) const {}
};
template <class Epi, class Sched>
__device__ __forceinline__ void gemm_phase(PG8_LAS unsigned char* lds, const Gemm g, const Sched& S, const Epi& E) {
    int tid_ = threadIdx.x; asm volatile("" : "+v"(tid_)); const int tid = tid_, wid = __builtin_amdgcn_readfirstlane(tid >> 6), lane = tid & 63, wr = wid >> 2, wc = wid & 3, fr = lane & 15, fq = lane >> 4;
    const int K = g.K, nt = K / BK;
    unsigned voffA[2], voffB[2];
#pragma unroll
    for (int i = 0; i < 2; ++i) { int R, C; stage_rc(tid * 16 + i * 8192, R, C); const int Rb = Epi::PERM ? ((R & ~31) + perm32(R & 31)) : R;
        voffA[i] = (unsigned)(R * K + C) * 2u; voffB[i] = (unsigned)(Rb * K + C) * 2u; }
    const size_t kstep = (size_t)(BK * 2);
    const size_t hstep = (size_t)HALF * K * 2;
    const size_t tstep = 2 * hstep;
    const unsigned ldsw = (unsigned)wid * 1024u;
    const int aoff = lds_byte(wr * 64 + fr, fq * 8), boff = lds_byte(wc * 32 + fr, fq * 8);
#define PG8_SA(b, h) (((b) * 2 + (h)) * HTB)
#define PG8_SB(b, h) ((4 + (b) * 2 + (h)) * HTB)
#define PG8_STAGE(bufoff, gbase, voff) do { _Pragma("unroll") for (int _i = 0; _i < 2; ++_i) \
        __builtin_amdgcn_global_load_lds((const unsigned*)((const char*)(gbase) + (voff)[_i]), (PG8_LAS unsigned*)(lds + (bufoff) + ldsw + _i * 8192), 16, 0, 0); } while (0)
#define PG8_LDA(dst, b, h) do { _Pragma("unroll") for (int m = 0; m < 4; ++m) _Pragma("unroll") for (int k = 0; k < 2; ++k) dst[m][k] = *(const PG8_LAS bf16x8*)(lds + PG8_SA(b, h) + aoff + m * 2048 + k * 1024); } while (0)
#define PG8_LDB(dst, b, h) do { _Pragma("unroll") for (int n = 0; n < 2; ++n) _Pragma("unroll") for (int k = 0; k < 2; ++k) dst[n][k] = *(const PG8_LAS bf16x8*)(lds + PG8_SB(b, h) + boff + n * 2048 + k * 1024); } while (0)
#define PG8_MMA(ai, bj, At, Bt) do { __builtin_amdgcn_s_setprio(1); _Pragma("unroll") for (int m = 0; m < 4; ++m) _Pragma("unroll") for (int n = 0; n < 2; ++n) _Pragma("unroll") for (int k = 0; k < 2; ++k) \
        acc[ai][bj][m][n] = __builtin_amdgcn_mfma_f32_16x16x32_bf16(Bt[n][k], At[m][k], acc[ai][bj][m][n], 0, 0, 0); __builtin_amdgcn_s_setprio(0); } while (0)
#define PG8_WAIT_V(n) asm volatile("s_waitcnt vmcnt(" #n ")" ::: "memory")
#define PG8_WAIT_L(n) asm volatile("s_waitcnt lgkmcnt(" #n ")" ::: "memory")
#define PG8_BAR __builtin_amdgcn_s_barrier()
#define PG8_SCHED __builtin_amdgcn_sched_barrier(0)
    Unit cur, nxt; int ui = 0;
    if (!S.next(0, cur)) return;
    f32x4 acc[2][2][4][2];
#pragma unroll
    for (int a = 0; a < 2; ++a)
#pragma unroll
        for (int b = 0; b < 2; ++b)
#pragma unroll
            for (int m = 0; m < 4; ++m)
#pragma unroll
                for (int n = 0; n < 2; ++n) acc[a][b][m][n] = (f32x4){0.f, 0.f, 0.f, 0.f};
    bf16x8 At[4][2], B0[2][2], B1[2][2];
    const char* cA = (const char*)g.A + (size_t)cur.pm * tstep; const char* cB = (const char*)g.Bt + (size_t)cur.pn * tstep;
    S.a_ready(cur);
    PG8_STAGE(PG8_SB(0, 0), cB, voffB); PG8_STAGE(PG8_SA(0, 0), cA, voffA); PG8_STAGE(PG8_SB(0, 1), cB + hstep, voffB); PG8_STAGE(PG8_SA(0, 1), cA + hstep, voffA);
    if (wr == 1) PG8_BAR;
    PG8_WAIT_V(4); PG8_BAR;
    PG8_STAGE(PG8_SB(1, 0), cB + kstep, voffB); PG8_STAGE(PG8_SA(1, 0), cA + kstep, voffA); PG8_STAGE(PG8_SB(1, 1), cB + hstep + kstep, voffB);
    PG8_WAIT_V(6); PG8_BAR;
    for (;;) {
        const bool has_next = S.next(ui + 1, nxt);
        const char* nA = has_next ? (const char*)g.A + (size_t)nxt.pm * tstep : cA; const char* nB = has_next ? (const char*)g.Bt + (size_t)nxt.pn * tstep : cB;
        for (int t = 0; t < nt; t += 2) {
            const bool last = (t == nt - 2);
            const char* a1 = cA + (size_t)(t + 1) * kstep;
            const char* a2 = last ? nA : cA + (size_t)(t + 2) * kstep; const char* b2 = last ? nB : cB + (size_t)(t + 2) * kstep;
            const char* a3 = a2 + kstep; const char* b3 = b2 + kstep;
            if (last && has_next) S.a_ready(nxt);
            PG8_LDB(B0, 0, 0); PG8_SCHED; PG8_LDA(At, 0, 0); PG8_STAGE(PG8_SA(1, 1), a1 + hstep, voffA);
            PG8_WAIT_L(8); PG8_BAR; PG8_WAIT_L(0); PG8_MMA(0, 0, At, B0); PG8_BAR; PG8_SCHED;
            PG8_LDB(B1, 0, 1); PG8_STAGE(PG8_SB(0, 0), b2, voffB);
            PG8_BAR; PG8_WAIT_L(0); PG8_MMA(0, 1, At, B1); PG8_BAR;
            PG8_LDA(At, 0, 1); PG8_STAGE(PG8_SA(0, 0), a2, voffA);
            PG8_BAR; PG8_WAIT_L(0); PG8_MMA(1, 0, At, B0); PG8_BAR; PG8_SCHED;
            PG8_STAGE(PG8_SB(0, 1), b2 + hstep, voffB);
            PG8_WAIT_V(6); PG8_BAR; PG8_MMA(1, 1, At, B1); PG8_BAR;
            PG8_LDB(B0, 1, 0); PG8_SCHED; PG8_LDA(At, 1, 0); PG8_STAGE(PG8_SA(0, 1), a2 + hstep, voffA);
            PG8_WAIT_L(8); PG8_BAR; PG8_WAIT_L(0); PG8_MMA(0, 0, At, B0); PG8_BAR; PG8_SCHED;
            PG8_LDB(B1, 1, 1); PG8_STAGE(PG8_SB(1, 0), b3, voffB);
            PG8_BAR; PG8_WAIT_L(0); PG8_MMA(0, 1, At, B1); PG8_BAR;
            PG8_LDA(At, 1, 1); PG8_STAGE(PG8_SA(1, 0), a3, voffA);
            PG8_BAR; PG8_WAIT_L(0); PG8_MMA(1, 0, At, B0); PG8_BAR; PG8_SCHED;
            PG8_STAGE(PG8_SB(1, 1), b3 + hstep, voffB);
            PG8_WAIT_V(6); PG8_BAR; PG8_MMA(1, 1, At, B1); PG8_BAR;
        }
        if constexpr (!Epi::AFTER_DRAIN) { E(acc, cur, wr, wc, fr, fq); S.done(cur); }
        if (!has_next) break;
#pragma unroll
        for (int a = 0; a < 2; ++a)
#pragma unroll
            for (int b = 0; b < 2; ++b)
#pragma unroll
                for (int m = 0; m < 4; ++m)
#pragma unroll
                    for (int n = 0; n < 2; ++n) acc[a][b][m][n] = (f32x4){0.f, 0.f, 0.f, 0.f};
        cur = nxt; cA = nA; cB = nB; ++ui;
    }
    PG8_WAIT_V(0);
    if (wr == 0) PG8_BAR;
    PG8_BAR;
    if constexpr (Epi::AFTER_DRAIN) { E.fused(acc, cur, wr, wc, fr, fq, lds, wid, lane); S.done(cur); }
#undef PG8_SA
#undef PG8_SB
#undef PG8_STAGE
#undef PG8_LDA
#undef PG8_LDB
#undef PG8_MMA
#undef PG8_WAIT_V
#undef PG8_WAIT_L
#undef PG8_BAR
#undef PG8_SCHED
}
}

#define LAS __attribute__((address_space(3)))
using pg8::bf16_t; using pg8::bf16x8; using pg8::f32x4;
typedef float f32x2 __attribute__((ext_vector_type(2)));
typedef unsigned u32x2 __attribute__((ext_vector_type(2)));
typedef unsigned u32x4v __attribute__((ext_vector_type(4)));

constexpr int D = 1024, DFF = 2816, DIN = 3072, DEPTH = 4;
constexpr int T_CTX = 8192, T_LAT = 32768, T = T_CTX + T_LAT;
constexpr int NCHUNK = T / 128;
constexpr int MODW = 9 * D;
constexpr float ALPHA_F = 1.6817928305074290f;
constexpr float EPS_F = 1e-5f;
constexpr int LDS_WORK = 139264;
constexpr int LDS_BYTES = LDS_WORK + 16;

constexpr size_t WS_X = 0;
constexpr size_t WS_H = WS_X + (size_t)T * D * 2;
constexpr size_t WS_MIX = WS_H + (size_t)T * D * 2;
constexpr size_t WS_U = WS_MIX + (size_t)T * D * 2;
constexpr size_t SZ_T512 = (size_t)T * 512 * 2;
constexpr size_t WS_RPT = WS_U + 6 * SZ_T512;
constexpr size_t WS_WT = WS_RPT + (size_t)2 * NCHUNK * 4 * 16384 * 2;
constexpr size_t WT_W1 = 0, WT_W2 = WT_W1 + (size_t)2 * 5632 * 1024, WT_WIN = WT_W2 + (size_t)2 * 1024 * 2816, WT_WOUT = WT_WIN + (size_t)3072 * 1024, WT_ELEMS = WT_WOUT + (size_t)1024 * 1024;
constexpr size_t WS_MOD = WS_WT + WT_ELEMS * 2;
constexpr size_t WS_ROPE = WS_MOD + (size_t)DEPTH * 9 * MODW * 4;
constexpr size_t WS_SLOT = WS_ROPE + 64 * 32 * 2 * 4;
constexpr size_t WS_CNT = WS_SLOT + (size_t)T * 16 * 8;
constexpr int N_CNT = 12 * 160 * 2;
constexpr size_t WS_BAR = WS_CNT + (size_t)N_CNT * 4;
constexpr size_t WS_END = WS_BAR + 3456 * 4;

constexpr size_t OUT_YS = 0, OUT_SF = (size_t)T * D, OUT_SB = OUT_SF + (size_t)32 * DEPTH * 4 * 16384;

struct Params {
    const float* in[19];
    float* out;
    unsigned char* ws;
    int ph_lo, ph_hi;
};
typedef const __attribute__((address_space(4))) Params* CP;
enum { I_XP = 0, I_XS, I_SF, I_SB, I_C, I_CCTX, I_WADA, I_BADA, I_LNG, I_LNB, I_W1, I_W2, I_WIN, I_WOUT, I_CW, I_CB, I_CLG, I_CLB, I_DEC };

__device__ __forceinline__ unsigned cvt_pk_bf16(float lo, float hi) { unsigned r; asm("v_cvt_pk_bf16_f32 %0, %1, %2" : "=v"(r) : "v"(lo), "v"(hi)); return r; }
__device__ __forceinline__ int my_tid() { int t = threadIdx.x; asm volatile("" : "+v"(t)); return t; }
__device__ __forceinline__ float bf_lo(unsigned u) { return __uint_as_float(u << 16); }
__device__ __forceinline__ float bf_hi(unsigned u) { return __uint_as_float(u & 0xffff0000u); }
__device__ __forceinline__ float fast_sigmoid(float x) { return __builtin_amdgcn_rcpf(1.0f + __expf(-x)); }
__device__ __forceinline__ float fast_silu(float x) { return x * fast_sigmoid(x); }
__device__ __forceinline__ int mod_row_of_tile(int pm) { return pm < 32 ? 0 : 1 + ((pm - 32) >> 4); }
__device__ __forceinline__ int mod_row_of_tok(int t) { return t < T_CTX ? 0 : 1 + ((t - T_CTX) >> 12); }
__device__ __forceinline__ float wave_sum(float v) {
#pragma unroll
    for (int o = 32; o >= 1; o >>= 1) v += __shfl_xor(v, o, 64);
    return v;
}
__device__ __forceinline__ float log_sigmoid_f(float x) { return -log1pf(__expf(-x)); }

struct EpiSwiglu {
    static constexpr bool PERM = true, AFTER_DRAIN = false;
    bf16_t* O;
    __device__ __forceinline__ void operator()(const f32x4 (&acc)[2][2][4][2], const pg8::Unit& u, int wr, int wc, int fr, int fq) const {
        const int row0 = u.pm * 256 + wr * 64 + fr, col0 = u.pn * 128 + wc * 32 + 8 * fq;
#pragma unroll
        for (int ai = 0; ai < 2; ++ai)
#pragma unroll
            for (int m = 0; m < 4; ++m) {
                bf16_t* dst = O + (size_t)(row0 + ai * 128 + m * 16) * DFF + col0;
                const f32x4 a0 = acc[ai][0][m][0], a1 = acc[ai][0][m][1], b0 = acc[ai][1][m][0], b1 = acc[ai][1][m][1];
                u32x4v o;
                o[0] = cvt_pk_bf16(fast_silu(a0[0]) * b0[0], fast_silu(a0[1]) * b0[1]);
                o[1] = cvt_pk_bf16(fast_silu(a0[2]) * b0[2], fast_silu(a0[3]) * b0[3]);
                o[2] = cvt_pk_bf16(fast_silu(a1[0]) * b1[0], fast_silu(a1[1]) * b1[1]);
                o[3] = cvt_pk_bf16(fast_silu(a1[2]) * b1[2], fast_silu(a1[3]) * b1[3]);
                *(u32x4v*)dst = o;
            }
    }
};
struct EpiResid {
    static constexpr bool PERM = false, AFTER_DRAIN = false;
    float* X; const float* gate; float gscale;
    __device__ __forceinline__ void operator()(const f32x4 (&acc)[2][2][4][2], const pg8::Unit& u, int wr, int wc, int fr, int fq) const {
        const int row0 = u.pm * 256 + wr * 64 + fr, col0 = u.pn * 256 + wc * 32 + 4 * fq;
        const float* gp = gate + (size_t)mod_row_of_tile(u.pm) * MODW + col0;
#pragma unroll
        for (int ai = 0; ai < 2; ++ai)
#pragma unroll
            for (int m = 0; m < 4; ++m) {
                float* rowp = X + (size_t)(row0 + ai * 128 + m * 16) * D + col0;
#pragma unroll
                for (int bj = 0; bj < 2; ++bj)
#pragma unroll
                    for (int n = 0; n < 2; ++n) {
                        const f32x4 gv = *(const f32x4*)(gp + bj * 128 + n * 16) * gscale;
                        f32x4 x = *(const f32x4*)(rowp + bj * 128 + n * 16);
                        x = x * ALPHA_F + gv * acc[ai][bj][m][n];
                        *(f32x4*)(rowp + bj * 128 + n * 16) = x;
                    }
            }
    }
};
struct QuadOrder {
    int nM, c;
    __device__ void init(int M, int c_) { nM = M / 256; c = c_; }
    __device__ bool next(int i, pg8::Unit& u) const {
        const int xcd = c & 7, k = c >> 3, full = nM >> 6;
        if (i < full) { u.pm = 64 * i + 8 * xcd + (k >> 2); u.pn = k & 3; return true; }
        if (i == full) { const int per = (nM - 64 * full) >> 3; if ((k >> 2) < per) { u.pm = 64 * full + per * xcd + (k >> 2); u.pn = k & 3; return true; } }
        return false;
    }
    __device__ __forceinline__ void a_ready(const pg8::Unit&) const {}
    __device__ __forceinline__ void done(const pg8::Unit&) const {}
};
typedef _Float16 f16x8 __attribute__((ext_vector_type(8)));
typedef float f32x8 __attribute__((ext_vector_type(8)));
struct EpiResLn {
    static constexpr bool PERM = true, AFTER_DRAIN = false;
    CP p; int l, sub; LAS unsigned char* ldsb;
    __device__ __forceinline__ void operator()(f32x4 (&acc)[2][2][4][2], const pg8::Unit& u, int wr, int wc, int fr, int fq) const {
        CP pp = p; asm volatile("" : "+s"(pp));
        f16x8* XP = (f16x8*)(pp->ws + WS_X); bf16_t* H = (bf16_t*)(pp->ws + WS_H);
        const bool fin = (l == DEPTH - 1 && sub == 2);
        float* OUT = pp->out;
        const float* MOD = (const float*)(pp->ws + WS_MOD);
        const float* gate = MOD + (size_t)l * 9 * MODW + (size_t)(sub == 1 ? 5 : (sub == 0 ? 2 : 8)) * D;
        const float gscale = sub == 1 ? 1.0f : 0.5f;
        const float* lng = pp->in[I_LNG] + (size_t)(l * 3 + sub) * D; const float* lnb = pp->in[I_LNB] + (size_t)(l * 3 + sub) * D;
        const int nl = sub == 2 ? (l + 1 < DEPTH ? l + 1 : l) : l, ns = sub == 2 ? 0 : sub + 1;
        const float* modn = MOD + (size_t)nl * 9 * MODW + (size_t)(3 * ns) * D;
        char* slots = (char*)(pp->ws + WS_SLOT); unsigned* cnt = (unsigned*)(pp->ws + WS_CNT) + (size_t)(l * 3 + sub) * 320;
        const int lane = fr + 16 * fq;
        const int row0 = u.pm * 256 + wr * 64 + fr, col0 = u.pn * 256 + wc * 32 + 8 * fq;
        const unsigned xp0 = (unsigned)((((u.pm * 4 + u.pn) * 8 + wr * 4 + wc) * 16) * 64 + lane);
        const int mrow = mod_row_of_tile(u.pm);
        const float* gp = gate + (size_t)mrow * MODW + col0;
        float s1[8], s2[8];
#pragma unroll
        for (int i = 0; i < 8; ++i) { s1[i] = 0.f; s2[i] = 0.f; }
        f16x8 xq[16];
#pragma unroll
        for (int gq = 0; gq < 16; ++gq) xq[gq] = XP[xp0 + (unsigned)(gq * 64)];
        __builtin_amdgcn_sched_barrier(0);
#pragma unroll
        for (int bj = 0; bj < 2; ++bj) {
            const f32x4 gv0 = *(const f32x4*)(gp + bj * 128) * gscale, gv1 = *(const f32x4*)(gp + bj * 128 + 4) * gscale;
#pragma unroll
            for (int ai = 0; ai < 2; ++ai)
#pragma unroll
                for (int m = 0; m < 4; ++m) {
                    const f32x8 x = __builtin_convertvector(xq[(ai * 2 + bj) * 4 + m], f32x8);
                    const f32x4 z0 = (f32x4){x[0], x[1], x[2], x[3]} * ALPHA_F + gv0 * acc[ai][bj][m][0];
                    const f32x4 z1 = (f32x4){x[4], x[5], x[6], x[7]} * ALPHA_F + gv1 * acc[ai][bj][m][1];
                    acc[ai][bj][m][0] = z0; acc[ai][bj][m][1] = z1;
                    s1[ai * 4 + m] += ((z0[0] + z0[1]) + (z0[2] + z0[3])) + ((z1[0] + z1[1]) + (z1[2] + z1[3]));
                    s2[ai * 4 + m] += ((z0[0] * z0[0] + z0[1] * z0[1]) + (z0[2] * z0[2] + z0[3] * z0[3])) + ((z1[0] * z1[0] + z1[1] * z1[1]) + (z1[2] * z1[2] + z1[3] * z1[3]));
                }
        }
#pragma unroll
        for (int i = 0; i < 8; ++i) { s1[i] += __shfl_xor(s1[i], 16, 64); s2[i] += __shfl_xor(s2[i], 16, 64); }
#pragma unroll
        for (int i = 0; i < 8; ++i) { s1[i] += __shfl_xor(s1[i], 32, 64); s2[i] += __shfl_xor(s2[i], 32, 64); }
        const unsigned so0 = (unsigned)(row0 * 64);
#pragma unroll
        for (int i = 0; i < 8; ++i) {
            if ((i >> 1) == fq) {
                const unsigned v = (unsigned)__builtin_bit_cast(unsigned short, (_Float16)s1[i]) | ((unsigned)__builtin_bit_cast(unsigned short, (_Float16)s2[i]) << 16);
                __hip_atomic_store((unsigned*)(slots + (so0 + (unsigned)(((i >> 2) * 128 + (i & 3) * 16) * 64) + (unsigned)((u.pn * 4 + wc) * 4))), v, __ATOMIC_RELAXED, __HIP_MEMORY_SCOPE_AGENT);
            }
        }
        asm volatile("s_waitcnt vmcnt(0)" ::: "memory");
        const float* mp = modn + (size_t)mrow * MODW + col0;
        const f32x4 pg0 = *(const f32x4*)(lng + col0), pg1 = *(const f32x4*)(lng + col0 + 4), pb0 = *(const f32x4*)(lnb + col0), pb1 = *(const f32x4*)(lnb + col0 + 4);
        unsigned* cp = cnt + (u.pm * 2 + wr);
        if (lane == 0) __hip_atomic_fetch_add(cp, 1u, __ATOMIC_RELAXED, __HIP_MEMORY_SCOPE_AGENT);
        const unsigned seq = (unsigned)((((l * 3 + sub) << 8) | u.pm) + 1);
        volatile LAS unsigned* fl = (volatile LAS unsigned*)(ldsb + LDS_WORK + 8 + 4 * wr);
        if (wc == 0) {
            for (int spins = 0; spins < (1 << 20); ++spins) {
                const unsigned v = __builtin_amdgcn_readfirstlane(__hip_atomic_load(cp, __ATOMIC_RELAXED, __HIP_MEMORY_SCOPE_AGENT));
                if (v >= 16u) break;
                __builtin_amdgcn_s_sleep(2);
            }
            if (lane == 0) *fl = seq;
        } else {
            for (int spins = 0; spins < (1 << 24); ++spins) {
                if ((unsigned)__builtin_amdgcn_readfirstlane((int)*fl) == seq) break;
                __builtin_amdgcn_s_sleep(1);
            }
        }
        unsigned xp1 = xp0, so1 = so0; asm volatile("" : "+v"(xp1), "+v"(so1));
        float mu[8], rs[8];
        const __amdgpu_buffer_rsrc_t srs = __builtin_amdgcn_make_buffer_rsrc((void*)slots, (short)0, (int)(T * 64), 0x00020000);
        {
            u32x4v sv[8];
#pragma unroll
            for (int i = 0; i < 8; ++i) sv[i] = __builtin_amdgcn_raw_buffer_load_b128(srs, so1 + (unsigned)(((i >> 2) * 128 + (i & 3) * 16) * 64) + (unsigned)(16 * fq), 0, 16);
            __builtin_amdgcn_sched_barrier(0);
            float sa[8], sb[8];
#pragma unroll
            for (int i = 0; i < 8; ++i) {
                float a = 0.f, b = 0.f;
#pragma unroll
                for (int q = 0; q < 4; ++q) { a += (float)__builtin_bit_cast(_Float16, (unsigned short)(sv[i][q] & 0xffffu)); b += (float)__builtin_bit_cast(_Float16, (unsigned short)(sv[i][q] >> 16)); }
                sa[i] = a; sb[i] = b;
            }
#pragma unroll
            for (int i = 0; i < 8; ++i) { sa[i] += __shfl_xor(sa[i], 16, 64); sb[i] += __shfl_xor(sb[i], 16, 64); }
#pragma unroll
            for (int i = 0; i < 8; ++i) { sa[i] += __shfl_xor(sa[i], 32, 64); sb[i] += __shfl_xor(sb[i], 32, 64); }
#pragma unroll
            for (int i = 0; i < 8; ++i) {
                const float m_ = sa[i] * (1.0f / D);
                mu[i] = m_; rs[i] = rsqrtf(fmaxf(sb[i] * (1.0f / D) - m_ * m_, 0.f) + EPS_F);
            }
        }
        const unsigned ro0 = (unsigned)(row0 * D + col0);
#pragma unroll
        for (int bj = 0; bj < 2; ++bj) {
            const int co = bj * 128;
            const f32x4 g0 = bj ? *(const f32x4*)(lng + col0 + co) : pg0, g1 = bj ? *(const f32x4*)(lng + col0 + co + 4) : pg1, b0 = bj ? *(const f32x4*)(lnb + col0 + co) : pb0, b1 = bj ? *(const f32x4*)(lnb + col0 + co + 4) : pb1;
            const f32x4 sh0 = *(const f32x4*)(mp + co), sh1 = *(const f32x4*)(mp + co + 4), sc0 = *(const f32x4*)(mp + D + co) + 1.0f, sc1 = *(const f32x4*)(mp + D + co + 4) + 1.0f;
#pragma unroll
            for (int ai = 0; ai < 2; ++ai)
#pragma unroll
                for (int m = 0; m < 4; ++m) {
                    const f32x4 x0 = (acc[ai][bj][m][0] - mu[ai * 4 + m]) * rs[ai * 4 + m] * g0 + b0, x1 = (acc[ai][bj][m][1] - mu[ai * 4 + m]) * rs[ai * 4 + m] * g1 + b1;
                    const unsigned ro = ro0 + (unsigned)((ai * 128 + m * 16) * D + co);
                    if (fin) { *(f32x4*)(OUT + ro) = x0; *(f32x4*)(OUT + ro + 4) = x1; }
                    else {
                        const f32x8 xv = (f32x8){x0[0], x0[1], x0[2], x0[3], x1[0], x1[1], x1[2], x1[3]};
                        XP[xp1 + (unsigned)(((ai * 2 + bj) * 4 + m) * 64)] = __builtin_convertvector(xv, f16x8);
                        const f32x4 h0 = x0 * sc0 + sh0, h1 = x1 * sc1 + sh1;
                        u32x4v o; o[0] = cvt_pk_bf16(h0[0], h0[1]); o[1] = cvt_pk_bf16(h0[2], h0[3]); o[2] = cvt_pk_bf16(h1[0], h1[1]); o[3] = cvt_pk_bf16(h1[2], h1[3]);
                        *(u32x4v*)(H + ro) = o;
                    }
                }
            __builtin_amdgcn_sched_barrier(0);
        }
    }
};
struct EpiMixIn {
    static constexpr bool PERM = true, AFTER_DRAIN = false;
    bf16_t *UPRE, *Q, *K, *KT, *VT, *SG; const float* rope;
    __device__ __forceinline__ void operator()(const f32x4 (&acc)[2][2][4][2], const pg8::Unit& u, int wr, int wc, int fr, int fq) const {
        const int row0 = u.pm * 256 + wr * 64 + fr;
        const int pn = u.pn;
        if (pn < 4) {
            const int col0 = pn * 128 + wc * 32 + 8 * fq;
#pragma unroll
            for (int ai = 0; ai < 2; ++ai)
#pragma unroll
                for (int m = 0; m < 4; ++m) {
                    const f32x4 a0 = acc[ai][0][m][0], a1 = acc[ai][0][m][1], b0 = acc[ai][1][m][0], b1 = acc[ai][1][m][1];
                    u32x4v o;
                    o[0] = cvt_pk_bf16(a0[0] * fast_sigmoid(b0[0]), a0[1] * fast_sigmoid(b0[1]));
                    o[1] = cvt_pk_bf16(a0[2] * fast_sigmoid(b0[2]), a0[3] * fast_sigmoid(b0[3]));
                    o[2] = cvt_pk_bf16(a1[0] * fast_sigmoid(b1[0]), a1[1] * fast_sigmoid(b1[1]));
                    o[3] = cvt_pk_bf16(a1[2] * fast_sigmoid(b1[2]), a1[3] * fast_sigmoid(b1[3]));
                    *(u32x4v*)(UPRE + (size_t)(row0 + ai * 128 + m * 16) * 512 + col0) = o;
                }
        } else if (pn < 8) {
            const bool isk = pn >= 6, lat = u.pm >= 32;
            const int head = 2 * (pn & 1) + (wc >> 1), colrot = wc & 1, dbase = 64 * colrot + 8 * fq;
            const float sc = isk ? 1.0f : 0.08838834764831845f;
            bf16_t* RM = isk ? K : Q;
#pragma unroll
            for (int ai = 0; ai < 2; ++ai)
#pragma unroll
                for (int m = 0; m < 4; ++m) {
                    const int row = row0 + ai * 128 + m * 16;
                    const int sp = (row - T_CTX) & 4095, pos = colrot ? (sp & 63) : (sp >> 6);
                    const float* rp = rope + (size_t)(pos * 32 + 8 * fq) * 2;
                    bf16_t* dst = RM + (size_t)row * 512 + head * 128 + dbase;
                    const int chunk = row >> 7, c = row & 127;
                    bf16_t* kt = KT + ((size_t)(chunk * 4 + head) * 128 + dbase) * 128 + c;
#pragma unroll
                    for (int n = 0; n < 2; ++n) {
                        const f32x4 x1 = acc[ai][0][m][n], x2 = acc[ai][1][m][n];
                        f32x4 o1, o2;
                        if (lat) {
                            const f32x4 csa = *(const f32x4*)(rp + 8 * n), csb = *(const f32x4*)(rp + 8 * n + 4);
                            o1[0] = x1[0] * csa[0] - x2[0] * csa[1]; o2[0] = x1[0] * csa[1] + x2[0] * csa[0];
                            o1[1] = x1[1] * csa[2] - x2[1] * csa[3]; o2[1] = x1[1] * csa[3] + x2[1] * csa[2];
                            o1[2] = x1[2] * csb[0] - x2[2] * csb[1]; o2[2] = x1[2] * csb[1] + x2[2] * csb[0];
                            o1[3] = x1[3] * csb[2] - x2[3] * csb[3]; o2[3] = x1[3] * csb[3] + x2[3] * csb[2];
                        } else { o1 = x1; o2 = x2; }
                        o1 *= sc; o2 *= sc;
                        u32x2 p1, p2;
                        p1[0] = cvt_pk_bf16(o1[0], o1[1]); p1[1] = cvt_pk_bf16(o1[2], o1[3]);
                        p2[0] = cvt_pk_bf16(o2[0], o2[1]); p2[1] = cvt_pk_bf16(o2[2], o2[3]);
                        *(u32x2*)(dst + 4 * n) = p1; *(u32x2*)(dst + 32 + 4 * n) = p2;
                        if (isk) {
#pragma unroll
                            for (int q = 0; q < 2; ++q) {
                                kt[(size_t)(4 * n + 2 * q) * 128] = (bf16_t)(p1[q] & 0xffffu); kt[(size_t)(4 * n + 2 * q + 1) * 128] = (bf16_t)(p1[q] >> 16);
                                kt[(size_t)(4 * n + 2 * q + 32) * 128] = (bf16_t)(p2[q] & 0xffffu); kt[(size_t)(4 * n + 2 * q + 33) * 128] = (bf16_t)(p2[q] >> 16);
                            }
                        }
                    }
                }
        } else if (pn < 10) {
#pragma unroll
            for (int ai = 0; ai < 2; ++ai)
#pragma unroll
                for (int m = 0; m < 4; ++m) {
                    const int row = row0 + ai * 128 + m * 16, chunk = row >> 7, c = row & 127;
#pragma unroll
                    for (int bj = 0; bj < 2; ++bj) {
                        const int head = 2 * (pn - 8) + bj, d0 = wc * 32 + 8 * fq;
                        bf16_t* vt = VT + ((size_t)(chunk * 4 + head) * 128 + d0) * 128 + c;
#pragma unroll
                        for (int n = 0; n < 2; ++n) {
                            const unsigned pa = cvt_pk_bf16(acc[ai][bj][m][n][0], acc[ai][bj][m][n][1]), pb = cvt_pk_bf16(acc[ai][bj][m][n][2], acc[ai][bj][m][n][3]);
                            vt[(size_t)(4 * n + 0) * 128] = (bf16_t)(pa & 0xffffu); vt[(size_t)(4 * n + 1) * 128] = (bf16_t)(pa >> 16);
                            vt[(size_t)(4 * n + 2) * 128] = (bf16_t)(pb & 0xffffu); vt[(size_t)(4 * n + 3) * 128] = (bf16_t)(pb >> 16);
                        }
                    }
                }
        } else {
            const int col0 = (pn - 10) * 256 + wc * 32 + 8 * fq;
#pragma unroll
            for (int ai = 0; ai < 2; ++ai)
#pragma unroll
                for (int m = 0; m < 4; ++m)
#pragma unroll
                    for (int bj = 0; bj < 2; ++bj) {
                        const f32x4 a0 = acc[ai][bj][m][0], a1 = acc[ai][bj][m][1];
                        u32x4v o;
                        o[0] = cvt_pk_bf16(fast_silu(a0[0]), fast_silu(a0[1])); o[1] = cvt_pk_bf16(fast_silu(a0[2]), fast_silu(a0[3]));
                        o[2] = cvt_pk_bf16(fast_silu(a1[0]), fast_silu(a1[1])); o[3] = cvt_pk_bf16(fast_silu(a1[2]), fast_silu(a1[3]));
                        *(u32x4v*)(SG + (size_t)(row0 + ai * 128 + m * 16) * 512 + col0 + bj * 128) = o;
                    }
        }
    }
};

__device__ __forceinline__ int wt_src_col(int mat, int np) {
    if (mat < 2) { const int t = np >> 8, bj = (np >> 7) & 1, j = np & 127; return bj * DFF + 128 * t + j; }
    if (mat == 4) {
        const int pn = np >> 8, bj = (np >> 7) & 1, j = np & 127;
        if (pn < 4) return bj * 512 + 128 * pn + j;
        if (pn < 8) { const int base = 1024 + 512 * ((pn - 4) >> 1), head = 2 * (pn & 1) + (j >> 6), e = j & 63; return base + head * 128 + (e < 32 ? e : e + 32) + 32 * bj; }
        return np;
    }
    return np;
}
__device__ void convert_weights(CP p, int layer, LAS unsigned char* lds, int start, int stride, int group, int jlo = 0, int jhi = 1 << 30) {
    const int tid = my_tid();
    bf16_t* WT = (bf16_t*)(p->ws + WS_WT);
    constexpr int LSTR = 264;
    const int ntile0 = group == 0 ? 2624 : (group == 1 ? 2272 : (group == 2 ? 352 : (group == 3 ? 1056 : 1568))), ntile = ntile0 < jhi ? ntile0 : jhi;
    const int kr = tid >> 3, n4 = (tid & 7) * 4;
    for (int j = jlo + start; j < ntile; j += 2 * stride) {
        f32x4 v[2][4]; bf16_t* drow[2]; int dKs[2]; bool ok[2];
#pragma unroll
        for (int u = 0; u < 2; ++u) {
            const int jj = j + u * stride; ok[u] = jj < ntile;
            const int jc = ok[u] ? jj : j;
            const int t = group == 0 ? jc : (group == 1 ? (jc < 1760 ? jc : jc + 352) : (group == 2 ? 1760 + jc : (group == 3 ? (jc < 704 ? jc : 1408 + (jc - 704)) : (jc < 704 ? 704 + jc : 1760 + (jc - 704)))));
            int mat, tl;
            if (t < 1408) { mat = t / 704; tl = t % 704; } else if (t < 2112) { mat = 2 + (t - 1408) / 352; tl = (t - 1408) % 352; } else if (t < 2496) { mat = 4; tl = t - 2112; } else { mat = 5; tl = t - 2496; }
            int Ks, Ns; const float* src; bf16_t* dst;
            if (mat < 2) { Ks = 1024; Ns = 5632; src = p->in[I_W1] + (size_t)(layer * 2 + mat) * 1024 * 5632; dst = WT + WT_W1 + (size_t)mat * 5632 * 1024; }
            else if (mat < 4) { Ks = 2816; Ns = 1024; src = p->in[I_W2] + (size_t)(layer * 2 + mat - 2) * 2816 * 1024; dst = WT + WT_W2 + (size_t)(mat - 2) * 1024 * 2816; }
            else if (mat == 4) { Ks = 1024; Ns = 3072; src = p->in[I_WIN] + (size_t)layer * 1024 * 3072; dst = WT + WT_WIN; }
            else { Ks = 1024; Ns = 1024; src = p->in[I_WOUT] + (size_t)layer * 1024 * 1024; dst = WT + WT_WOUT; }
            const int nkt = Ks >> 8, nt = tl / nkt, kt = tl % nkt;
            const int c0 = wt_src_col(mat, nt * 32);
            drow[u] = dst + (size_t)(nt * 32) * Ks + kt * 256; dKs[u] = Ks;
#pragma unroll
            for (int i = 0; i < 4; ++i) v[u][i] = *(const f32x4*)(src + (size_t)(kt * 256 + kr + 64 * i) * Ns + c0 + n4);
        }
#pragma unroll
        for (int u = 0; u < 2; ++u) {
            LAS bf16_t* L = (LAS bf16_t*)lds + u * (32 * LSTR);
#pragma unroll
            for (int i = 0; i < 4; ++i) {
                const unsigned a = cvt_pk_bf16(v[u][i][0], v[u][i][1]), b = cvt_pk_bf16(v[u][i][2], v[u][i][3]);
                const int k = kr + 64 * i;
                L[(n4 + 0) * LSTR + k] = (bf16_t)(a & 0xffffu); L[(n4 + 1) * LSTR + k] = (bf16_t)(a >> 16);
                L[(n4 + 2) * LSTR + k] = (bf16_t)(b & 0xffffu); L[(n4 + 3) * LSTR + k] = (bf16_t)(b >> 16);
            }
        }
        __syncthreads();
#pragma unroll
        for (int u = 0; u < 2; ++u) {
            if (ok[u]) {
                LAS bf16_t* L = (LAS bf16_t*)lds + u * (32 * LSTR);
                const int n = tid >> 4, kc = (tid & 15) * 16;
                const u32x4v r0 = *(const LAS u32x4v*)(L + n * LSTR + kc), r1 = *(const LAS u32x4v*)(L + n * LSTR + kc + 8);
                bf16_t* d = drow[u] + (size_t)n * dKs[u] + kc;
                *(u32x4v*)d = r0; *(u32x4v*)(d + 8) = r1;
            }
        }
        __syncthreads();
    }
}

__device__ void phase_prep(CP p, LAS unsigned char* lds) {
    const int tid = my_tid();
    float* MOD = (float*)(p->ws + WS_MOD);
    if (blockIdx.x == gridDim.x - 1) {
        float* rope = (float*)(p->ws + WS_ROPE);
        for (int e = tid; e < 2048; e += 512) {
            const int pos = e >> 5, f = e & 31;
            const float inv = exp2f(-(float)f * (13.287712379549449f / 32.0f));
            const float x = (float)pos * inv;
            const float r = x - 6.283185307179586f * rintf(x * 0.15915494309189535f);
            rope[2 * e] = cosf(r); rope[2 * e + 1] = sinf(r);
        }
    }
    if (blockIdx.x < 144) {
        LAS float* S = (LAS float*)lds;
        LAS float* R = (LAS float*)(lds + 9 * 1024 * 4);
        for (int i = tid; i < 9 * 1024; i += 512) {
            const int r = i >> 10, k = i & 1023;
            const float c = r == 0 ? p->in[I_CCTX][k] : p->in[I_C][(r - 1) * 1024 + k];
            S[i] = c / (1.0f + __expf(-c));
        }
        __syncthreads();
        for (int task = blockIdx.x; task < 144; task += gridDim.x) {
            const int l = task / 36, j0 = (task % 36) * 256;
            const int cq = tid & 63, ks = tid >> 6;
            const float* w = p->in[I_WADA] + ((size_t)l * 1024 + ks * 128) * MODW + j0 + 4 * cq;
            f32x4 acc[9];
#pragma unroll
            for (int r = 0; r < 9; ++r) acc[r] = (f32x4){0.f, 0.f, 0.f, 0.f};
#pragma unroll 4
            for (int k = 0; k < 128; ++k) {
                const f32x4 wv = *(const f32x4*)(w + (size_t)k * MODW);
#pragma unroll
                for (int r = 0; r < 9; ++r) acc[r] += wv * S[r * 1024 + ks * 128 + k];
            }
#pragma unroll
            for (int r = 0; r < 9; ++r) *(LAS f32x4*)(R + (ks * 9 + r) * 256 + 4 * cq) = acc[r];
            __syncthreads();
            for (int i = tid; i < 9 * 256; i += 512) {
                const int r = i >> 8, c = i & 255;
                float s = p->in[I_BADA][(size_t)l * MODW + j0 + c];
#pragma unroll
                for (int q = 0; q < 8; ++q) s += R[(q * 9 + r) * 256 + c];
                MOD[((size_t)l * 9 + r) * MODW + j0 + c] = s;
            }
            __syncthreads();
        }
    }
    {
        const bool nomod = blockIdx.x >= 144; const int split = 6 * 112;
        convert_weights(p, 0, lds, nomod ? (int)blockIdx.x - 144 : (int)blockIdx.x, nomod ? 112 : 144, 3, nomod ? 0 : split, nomod ? split : (1 << 30));
    }
    {
        unsigned* cnt = (unsigned*)(p->ws + WS_CNT);
        for (int i = blockIdx.x * 512 + tid; i < N_CNT; i += gridDim.x * 512) cnt[i] = 0u;
    }
}

__device__ void phase_init(CP p) {
    const int tid = my_tid();
    f16x8* XP = (f16x8*)(p->ws + WS_X); bf16_t* H = (bf16_t*)(p->ws + WS_H);
    const float* MOD = (const float*)(p->ws + WS_MOD);
    for (unsigned pc = blockIdx.x * 512 + tid; pc < (unsigned)(T / 256) * 4 * 8 * 16 * 64; pc += gridDim.x * 512) {
        const int lane = pc & 63, g = (pc >> 6) & 15, w = (pc >> 10) & 7, pn = (pc >> 13) & 3, pm = pc >> 15;
        const int fr = lane & 15, fq = lane >> 4, wr = w >> 2, wc = w & 3, ai = g >> 3, bj = (g >> 2) & 1, m = g & 3;
        const int row = pm * 256 + ai * 128 + wr * 64 + m * 16 + fr, col = pn * 256 + bj * 128 + wc * 32 + 8 * fq;
        const float* src = row < T_CTX ? p->in[I_XP] + (size_t)row * D + col : p->in[I_XS] + (size_t)(row - T_CTX) * D + col;
        const f32x4 x0 = *(const f32x4*)src, x1 = *(const f32x4*)(src + 4);
        const f32x8 xv = (f32x8){x0[0], x0[1], x0[2], x0[3], x1[0], x1[1], x1[2], x1[3]};
        XP[pc] = __builtin_convertvector(xv, f16x8);
        const float* mp = MOD + (size_t)mod_row_of_tok(row) * MODW + col;
        const f32x4 h0 = x0 * (*(const f32x4*)(mp + D) + 1.0f) + *(const f32x4*)mp, h1 = x1 * (*(const f32x4*)(mp + D + 4) + 1.0f) + *(const f32x4*)(mp + 4);
        u32x4v o; o[0] = cvt_pk_bf16(h0[0], h0[1]); o[1] = cvt_pk_bf16(h0[2], h0[3]); o[2] = cvt_pk_bf16(h1[0], h1[1]); o[3] = cvt_pk_bf16(h1[2], h1[3]);
        *(u32x4v*)(H + (size_t)row * D + col) = o;
    }
}

__device__ __forceinline__ bf16x8 scale_frag(bf16x8 f, const float (&s)[8]) {
    u32x4v u = __builtin_bit_cast(u32x4v, f), o;
#pragma unroll
    for (int q = 0; q < 4; ++q) o[q] = cvt_pk_bf16(bf_lo(u[q]) * s[2 * q], bf_hi(u[q]) * s[2 * q + 1]);
    return __builtin_bit_cast(bf16x8, o);
}
struct KvSet { bf16x8 a[4]; bf16x8 b[2][4]; };
__device__ void kv_scan_unit(CP p, int layer, int unit) {
    const int tid = my_tid(), w = tid >> 6, lane = tid & 63, l15 = lane & 15, g = lane >> 4;
    int s, h, dir, sl;
    if (unit < 256) { sl = unit & 3; dir = (unit >> 2) & 1; h = (unit >> 3) & 3; s = 32 + (unit >> 5); }
    else { const int u = unit - 256; sl = u & 3; dir = (u >> 2) & 1; h = (u >> 3) & 3; s = u >> 5; }
    const bool lat = s >= 32;
    const int nch = lat ? 32 : 2, chunk0 = lat ? 64 + 32 * (s - 32) : 2 * s;
    const bf16_t* KT = (const bf16_t*)(p->ws + WS_U + 3 * SZ_T512); const bf16_t* VT = (const bf16_t*)(p->ws + WS_U + 4 * SZ_T512);
    bf16_t* RPT = (bf16_t*)(p->ws + WS_RPT);
    const float lg = log_sigmoid_f(p->in[I_DEC][(layer * 2 + dir) * 4 + h]);
    const float cd = __expf(lg * 128.0f);
    float kj[8], kb[4];
#pragma unroll
    for (int j = 0; j < 8; ++j) kj[j] = __expf(lg * (float)(dir == 0 ? -j : j));
#pragma unroll
    for (int kk = 0; kk < 4; ++kk) kb[kk] = __expf(lg * (float)(dir == 0 ? 127 - 32 * kk - 8 * g : 32 * kk + 8 * g));
    const int dk0 = 16 * w + 4 * g;
    f32x4 acc[2];
#pragma unroll
    for (int nb = 0; nb < 2; ++nb) {
        if (lat) {
            const float* r0 = p->in[dir == 0 ? I_SF : I_SB] + ((size_t)((s - 32) * DEPTH + layer) * 4 + h) * 16384;
            const int dv = 32 * sl + 16 * nb + l15;
#pragma unroll
            for (int i = 0; i < 4; ++i) acc[nb][i] = r0[(size_t)(dk0 + i) * 128 + dv];
        } else acc[nb] = (f32x4){0.f, 0.f, 0.f, 0.f};
    }
    const bf16_t* kbase = KT + ((size_t)h * 128 + 16 * w + l15) * 128 + 8 * g;
    const bf16_t* vbase = VT + ((size_t)h * 128 + 32 * sl + l15) * 128 + 8 * g;
    auto chunk_of = [&](int i) { return chunk0 + (dir == 0 ? i : nch - 1 - i); };
    auto load_set = [&](KvSet& S, int i) {
        const size_t co = (size_t)chunk_of(i) * 4 * 16384;
#pragma unroll
        for (int kk = 0; kk < 4; ++kk) {
            S.a[kk] = *(const bf16x8*)(kbase + co + 32 * kk);
            S.b[0][kk] = *(const bf16x8*)(vbase + co + 32 * kk);
            S.b[1][kk] = *(const bf16x8*)(vbase + co + 16 * 128 + 32 * kk);
        }
    };
    auto step = [&](const KvSet& S, int i) {
        const int chunk = chunk_of(i);
#pragma unroll
        for (int nb = 0; nb < 2; ++nb) {
            const int dv = 32 * sl + 16 * nb + l15;
            u32x2 o; o[0] = cvt_pk_bf16(acc[nb][0], acc[nb][1]); o[1] = cvt_pk_bf16(acc[nb][2], acc[nb][3]);
            *(u32x2*)(RPT + (((size_t)(dir * NCHUNK + chunk) * 4 + h) * 128 + dv) * 128 + dk0) = o;
            acc[nb] *= cd;
        }
#pragma unroll
        for (int kk = 0; kk < 4; ++kk) {
            float sc[8];
#pragma unroll
            for (int j = 0; j < 8; ++j) sc[j] = kb[kk] * kj[j];
            const bf16x8 ak = scale_frag(S.a[kk], sc);
#pragma unroll
            for (int nb = 0; nb < 2; ++nb) acc[nb] = __builtin_amdgcn_mfma_f32_16x16x32_bf16(ak, S.b[nb][kk], acc[nb], 0, 0, 0);
        }
    };
    KvSet s0, s1, s2;
    load_set(s0, 0); load_set(s1, 1);
    for (int i = 0; i < nch; i += 3) {
        if (i + 2 < nch) load_set(s2, i + 2);
        step(s0, i);
        if (i + 1 < nch) { if (i + 3 < nch) load_set(s0, i + 3); step(s1, i + 1); }
        if (i + 2 < nch) { if (i + 4 < nch) load_set(s1, i + 4); step(s2, i + 2); }
    }
    if (!lat) {
        float* o = p->out + (dir == 0 ? OUT_SF : OUT_SB) + ((size_t)(s * DEPTH + layer) * 4 + h) * 16384;
#pragma unroll
        for (int nb = 0; nb < 2; ++nb) {
            const int dv = 32 * sl + 16 * nb + l15;
#pragma unroll
            for (int i = 0; i < 4; ++i) o[(size_t)(dk0 + i) * 128 + dv] = acc[nb][i];
        }
    }
}
__device__ void conv_units(CP p, int layer, LAS unsigned char* lds) {
    const int tid = my_tid(), lane = tid & 63, w = tid >> 6;
    const bf16_t* UPRE = (const bf16_t*)(p->ws + WS_U);
    bf16_t* MIX = (bf16_t*)(p->ws + WS_MIX);
    LAS unsigned char* lin = lds; LAS unsigned char* lout = lds + 62 * 1024;
    const int cp = tid & 255, th = tid >> 8;
    const float* cw = p->in[I_CW] + (size_t)layer * 31 * 512 + 2 * cp;
    f32x2 wgt[31];
#pragma unroll
    for (int j = 0; j < 31; ++j) wgt[j] = *(const f32x2*)(cw + (size_t)j * 512);
    const f32x2 bias = *(const f32x2*)(p->in[I_CB] + (size_t)layer * 512 + 2 * cp);
    const float* lg = p->in[I_CLG] + (size_t)layer * 512; const float* lb = p->in[I_CLB] + (size_t)layer * 512;
    const f32x4 g0 = *(const f32x4*)(lg + 4 * lane), g1 = *(const f32x4*)(lg + 256 + 4 * lane), b0 = *(const f32x4*)(lb + 4 * lane), b1 = *(const f32x4*)(lb + 256 + 4 * lane);
    u32x4v pre[8];
    auto issue = [&](int cu) {
        const int tok0 = cu * 32;
        int seg0, seg1;
        if (tok0 < T_CTX) { seg0 = tok0 & ~255; seg1 = seg0 + 256; } else { seg0 = tok0 & ~63; seg1 = seg0 + 64; }
#pragma unroll
        for (int k = 0; k < 8; ++k) {
            const int idx = tid + 512 * k, row = idx >> 6, ch = idx & 63, gr = tok0 - 15 + row;
            u32x4v v = (u32x4v){0u, 0u, 0u, 0u};
            if (idx < 62 * 64 && gr >= seg0 && gr < seg1) v = *(const u32x4v*)(UPRE + (size_t)gr * 512 + ch * 8);
            pre[k] = v;
        }
    };
    int cu = blockIdx.x;
    if (cu < 1280) issue(cu);
    for (; cu < 1280; cu += gridDim.x) {
        const int tok0 = cu * 32;
#pragma unroll
        for (int k = 0; k < 8; ++k) { const int idx = tid + 512 * k; if (idx < 62 * 64) *(LAS u32x4v*)(lin + (idx >> 6) * 1024 + (idx & 63) * 16) = pre[k]; }
        __syncthreads();
        if (cu + (int)gridDim.x < 1280) issue(cu + gridDim.x);
        f32x2 o[16];
#pragma unroll
        for (int t = 0; t < 16; ++t) o[t] = bias;
#pragma unroll
        for (int s = 0; s < 46; ++s) {
            const unsigned u = *(const LAS unsigned*)(lin + (16 * th + s) * 1024 + cp * 4);
            const f32x2 x = (f32x2){bf_lo(u), bf_hi(u)};
#pragma unroll
            for (int t = 0; t < 16; ++t) { if (s - t >= 0 && s - t <= 30) o[t] += wgt[s - t] * x; }
        }
#pragma unroll
        for (int t = 0; t < 16; ++t) *(LAS f32x2*)(lout + (16 * th + t) * 2048 + cp * 8) = o[t];
        __syncthreads();
#pragma unroll 2
        for (int tt = 0; tt < 4; ++tt) {
            const int t = 4 * w + tt;
            f32x4 v0 = *(const LAS f32x4*)(lout + t * 2048 + lane * 16), v1 = *(const LAS f32x4*)(lout + t * 2048 + 1024 + lane * 16);
            const float mu = wave_sum(v0[0] + v0[1] + v0[2] + v0[3] + v1[0] + v1[1] + v1[2] + v1[3]) * (1.0f / 512.0f);
            v0 -= mu; v1 -= mu;
            const float var = wave_sum(v0[0] * v0[0] + v0[1] * v0[1] + v0[2] * v0[2] + v0[3] * v0[3] + v1[0] * v1[0] + v1[1] * v1[1] + v1[2] * v1[2] + v1[3] * v1[3]) * (1.0f / 512.0f);
            const float rstd = rsqrtf(var + EPS_F);
            v0 = v0 * rstd * g0 + b0; v1 = v1 * rstd * g1 + b1;
            u32x2 q0, q1;
            q0[0] = cvt_pk_bf16(fast_silu(v0[0]), fast_silu(v0[1])); q0[1] = cvt_pk_bf16(fast_silu(v0[2]), fast_silu(v0[3]));
            q1[0] = cvt_pk_bf16(fast_silu(v1[0]), fast_silu(v1[1])); q1[1] = cvt_pk_bf16(fast_silu(v1[2]), fast_silu(v1[3]));
            bf16_t* dst = MIX + (size_t)(tok0 + t) * D;
            *(u32x2*)(dst + 4 * lane) = q0; *(u32x2*)(dst + 256 + 4 * lane) = q1;
        }
    }
    __syncthreads();
}
struct KvStep { int lat, s, h, dir, sl, i, nch, chunk; };
__device__ __forceinline__ KvStep kv_step(int j) {
    KvStep k; int u;
    if (j < 32) { u = blockIdx.x; k.lat = 1; k.i = j; k.nch = 32; k.s = 32 + (u >> 5); }
    else { u = blockIdx.x + 256 * ((j - 32) >> 1); k.lat = 0; k.i = (j - 32) & 1; k.nch = 2; k.s = u >> 5; }
    k.sl = u & 3; k.dir = (u >> 2) & 1; k.h = (u >> 3) & 3;
    const int chunk0 = k.lat ? 64 + 32 * (k.s - 32) : 2 * k.s;
    k.chunk = chunk0 + (k.dir == 0 ? k.i : k.nch - 1 - k.i);
    return k;
}
struct KvRegs { bf16x8 a[4]; u32x4v b; };
__device__ void kv_scan_stream(CP p, int layer, LAS unsigned char* lds) {
    const int tid = my_tid(), w = tid >> 6, lane = tid & 63, l15 = lane & 15, g = lane >> 4;
    const bf16_t* KT = (const bf16_t*)(p->ws + WS_U + 3 * SZ_T512); const bf16_t* VT = (const bf16_t*)(p->ws + WS_U + 4 * SZ_T512);
    bf16_t* RPT = (bf16_t*)(p->ws + WS_RPT);
    constexpr int NSTEP = 40, BRS = 272, BSLOT = 32 * BRS;
    const int dk0 = 16 * w + 4 * g;
    auto issue = [&](KvRegs& S, int j) {
        const KvStep k = kv_step(j);
        const bf16_t* kb = KT + ((size_t)(k.chunk * 4 + k.h) * 128 + 16 * w + l15) * 128 + 8 * g;
#pragma unroll
        for (int kk = 0; kk < 4; ++kk) S.a[kk] = *(const bf16x8*)(kb + 32 * kk);
        S.b = *(const u32x4v*)(VT + ((size_t)(k.chunk * 4 + k.h) * 128 + 32 * k.sl + (tid >> 4)) * 128 + (tid & 15) * 8);
    };
    f32x4 acc[2] = {(f32x4){0.f, 0.f, 0.f, 0.f}, (f32x4){0.f, 0.f, 0.f, 0.f}};
    float cd = 0.f, kj[8], kb4[4];
#pragma unroll
    for (int j = 0; j < 8; ++j) kj[j] = 0.f;
#pragma unroll
    for (int kk = 0; kk < 4; ++kk) kb4[kk] = 0.f;
    auto body = [&](KvRegs& S, int j) {
        const KvStep k = kv_step(j);
        LAS unsigned char* slot = lds + (j & 1) * BSLOT;
        *(LAS u32x4v*)(slot + (tid >> 4) * BRS + (tid & 15) * 16) = S.b;
        __syncthreads();
        if (k.i == 0) {
            const float lg = log_sigmoid_f(p->in[I_DEC][(layer * 2 + k.dir) * 4 + k.h]);
            cd = __expf(lg * 128.0f);
#pragma unroll
            for (int jj = 0; jj < 8; ++jj) kj[jj] = __expf(lg * (float)(k.dir == 0 ? -jj : jj));
#pragma unroll
            for (int kk = 0; kk < 4; ++kk) kb4[kk] = __expf(lg * (float)(k.dir == 0 ? 127 - 32 * kk - 8 * g : 32 * kk + 8 * g));
#pragma unroll
            for (int nb = 0; nb < 2; ++nb) {
                if (k.lat) {
                    const float* r0 = p->in[k.dir == 0 ? I_SF : I_SB] + ((size_t)((k.s - 32) * DEPTH + layer) * 4 + k.h) * 16384;
                    const int dv = 32 * k.sl + 16 * nb + l15;
#pragma unroll
                    for (int i = 0; i < 4; ++i) acc[nb][i] = r0[(size_t)(dk0 + i) * 128 + dv];
                } else acc[nb] = (f32x4){0.f, 0.f, 0.f, 0.f};
            }
        }
#pragma unroll
        for (int nb = 0; nb < 2; ++nb) {
            const int dv = 32 * k.sl + 16 * nb + l15;
            u32x2 o; o[0] = cvt_pk_bf16(acc[nb][0], acc[nb][1]); o[1] = cvt_pk_bf16(acc[nb][2], acc[nb][3]);
            *(u32x2*)(RPT + (((size_t)(k.dir * NCHUNK + k.chunk) * 4 + k.h) * 128 + dv) * 128 + dk0) = o;
            acc[nb] *= cd;
        }
#pragma unroll
        for (int kk = 0; kk < 4; ++kk) {
            float sc[8];
#pragma unroll
            for (int jj = 0; jj < 8; ++jj) sc[jj] = kb4[kk] * kj[jj];
            const bf16x8 ak = scale_frag(S.a[kk], sc);
#pragma unroll
            for (int nb = 0; nb < 2; ++nb) {
                const bf16x8 bfr = *(const LAS bf16x8*)(slot + (16 * nb + l15) * BRS + (32 * kk + 8 * g) * 2);
                acc[nb] = __builtin_amdgcn_mfma_f32_16x16x32_bf16(ak, bfr, acc[nb], 0, 0, 0);
            }
        }
        if (!k.lat && k.i == k.nch - 1) {
            float* o = p->out + (k.dir == 0 ? OUT_SF : OUT_SB) + ((size_t)(k.s * DEPTH + layer) * 4 + k.h) * 16384;
#pragma unroll
            for (int nb = 0; nb < 2; ++nb) {
                const int dv = 32 * k.sl + 16 * nb + l15;
#pragma unroll
                for (int i = 0; i < 4; ++i) o[(size_t)(dk0 + i) * 128 + dv] = acc[nb][i];
            }
        }
        if (j + 5 < NSTEP) issue(S, j + 5);
    };
    KvRegs s0, s1, s2, s3, s4;
    issue(s0, 0); issue(s1, 1); issue(s2, 2); issue(s3, 3); issue(s4, 4);
    for (int j = 0; j < NSTEP; j += 5) { body(s0, j); body(s1, j + 1); body(s2, j + 2); body(s3, j + 3); body(s4, j + 4); }
    __syncthreads();
}
__device__ void phase_mix2(CP p, int layer, LAS unsigned char* lds) {
    kv_scan_stream(p, layer, lds);
    conv_units(p, layer, lds);
}

__device__ void phase_mix3(CP p, int layer, LAS unsigned char* lds) {
    const int tid = my_tid(), w = tid >> 6, lane = tid & 63, l15 = lane & 15, g = lane >> 4;
    const bf16_t* Q = (const bf16_t*)(p->ws + WS_U + 1 * SZ_T512); const bf16_t* K = (const bf16_t*)(p->ws + WS_U + 2 * SZ_T512);
    const bf16_t* VT = (const bf16_t*)(p->ws + WS_U + 4 * SZ_T512); const bf16_t* SG = (const bf16_t*)(p->ws + WS_U + 5 * SZ_T512);
    const bf16_t* RPT = (const bf16_t*)(p->ws + WS_RPT);
    bf16_t* MIX = (bf16_t*)(p->ws + WS_MIX);
    constexpr int RS = 272, BUF = 128 * RS;
    LAS unsigned char* Ks = lds; LAS unsigned char* VTs = lds + BUF; LAS unsigned char* RfT = lds + 2 * BUF; LAS unsigned char* RbT = lds + 3 * BUF;
    u32x4v pre[16]; bf16x8 qpre[4];
    auto issue = [&](int pt) {
        const int chunk = pt >> 2, h = pt & 3, tok0 = chunk * 128;
#pragma unroll
        for (int i = 0; i < 4; ++i) {
            const int idx = tid + 512 * i, row = idx >> 4, ch = idx & 15;
            pre[4 * i + 0] = *(const u32x4v*)(K + (size_t)(tok0 + row) * 512 + h * 128 + ch * 8);
            pre[4 * i + 1] = *(const u32x4v*)(VT + ((size_t)(chunk * 4 + h) * 128 + row) * 128 + ch * 8);
            pre[4 * i + 2] = *(const u32x4v*)(RPT + (((size_t)chunk * 4 + h) * 128 + row) * 128 + ch * 8);
            pre[4 * i + 3] = *(const u32x4v*)(RPT + (((size_t)(NCHUNK + chunk) * 4 + h) * 128 + row) * 128 + ch * 8);
        }
#pragma unroll
        for (int kk = 0; kk < 4; ++kk) qpre[kk] = *(const bf16x8*)(Q + (size_t)(tok0 + 16 * w + l15) * 512 + h * 128 + 32 * kk + 8 * g);
    };
    if ((int)blockIdx.x < NCHUNK * 4) issue(blockIdx.x);
    for (int pt = blockIdx.x; pt < NCHUNK * 4; pt += gridDim.x) {
        const int chunk = pt >> 2, h = pt & 3, tok0 = chunk * 128;
#pragma unroll
        for (int i = 0; i < 4; ++i) {
            const int idx = tid + 512 * i, row = idx >> 4, ch = idx & 15;
            *(LAS u32x4v*)(Ks + row * RS + ch * 16) = pre[4 * i + 0]; *(LAS u32x4v*)(VTs + row * RS + ch * 16) = pre[4 * i + 1];
            *(LAS u32x4v*)(RfT + row * RS + ch * 16) = pre[4 * i + 2]; *(LAS u32x4v*)(RbT + row * RS + ch * 16) = pre[4 * i + 3];
        }
        int c = 16 * w + l15;
        asm volatile("" : "+v"(c));
        bf16x8 qf[4], qff[4], qfb[4];
        const float lgf = log_sigmoid_f(p->in[I_DEC][(layer * 2 + 0) * 4 + h]), lgb = log_sigmoid_f(p->in[I_DEC][(layer * 2 + 1) * 4 + h]);
        const float lf2 = lgf * 1.4426950408889634f, lb2 = lgb * 1.4426950408889634f;
#pragma unroll
        for (int kk = 0; kk < 4; ++kk) qf[kk] = qpre[kk];
        __syncthreads();
        if (pt + (int)gridDim.x < NCHUNK * 4) issue(pt + gridDim.x);
        u32x2 sgv[8];
        {
            const bf16_t* sgq = SG + (size_t)(tok0 + c) * 512 + h * 128 + 4 * g;
#pragma unroll
            for (int mb = 0; mb < 8; ++mb) sgv[mb] = *(const u32x2*)(sgq + 16 * mb);
        }
        u32x4v pf[4];
#pragma unroll
        for (int t = 0; t < 8; ++t) {
            f32x4 sacc = (f32x4){0.f, 0.f, 0.f, 0.f};
#pragma unroll
            for (int kk = 0; kk < 4; ++kk) {
                const bf16x8 a = *(const LAS bf16x8*)(Ks + (16 * t + l15) * RS + (32 * kk + 8 * g) * 2);
                sacc = __builtin_amdgcn_mfma_f32_16x16x32_bf16(a, qf[kk], sacc, 0, 0, 0);
            }
#pragma unroll
            for (int i = 0; i < 4; ++i) {
                const float dist = (float)(c - (16 * t + 4 * g + i));
                const float df = __builtin_amdgcn_exp2f(fmaf(lf2, dist, -1000.0f * fmaxf(-dist, 0.f))), db = __builtin_amdgcn_exp2f(fmaf(-lb2, dist, -1000.0f * fmaxf(dist, 0.f)));
                sacc[i] *= (df + db);
            }
            pf[t >> 1][2 * (t & 1)] = cvt_pk_bf16(sacc[0], sacc[1]); pf[t >> 1][2 * (t & 1) + 1] = cvt_pk_bf16(sacc[2], sacc[3]);
            if (t & 1) __builtin_amdgcn_sched_barrier(0);
        }
        f32x4 o[8];
#pragma unroll
        for (int mb = 0; mb < 8; ++mb) o[mb] = (f32x4){0.f, 0.f, 0.f, 0.f};
#pragma unroll
        for (int s = 0; s < 4; ++s) {
            const bf16x8 pb = __builtin_bit_cast(bf16x8, pf[s]);
#pragma unroll
            for (int mb = 0; mb < 8; ++mb) {
                const u32x2 lo = *(const LAS u32x2*)(VTs + (16 * mb + l15) * RS + (32 * s + 4 * g) * 2), hi = *(const LAS u32x2*)(VTs + (16 * mb + l15) * RS + (32 * s + 16 + 4 * g) * 2);
                const u32x4v av = (u32x4v){lo[0], lo[1], hi[0], hi[1]};
                o[mb] = __builtin_amdgcn_mfma_f32_16x16x32_bf16(__builtin_bit_cast(bf16x8, av), pb, o[mb], 0, 0, 0);
            }
            __builtin_amdgcn_sched_barrier(0);
        }
        __builtin_amdgcn_sched_barrier(0);
        {
            const float df = __expf(lgf * (float)(c + 1)), db = __expf(lgb * (float)(128 - c));
            float sf[8], sb[8];
#pragma unroll
            for (int j = 0; j < 8; ++j) { sf[j] = df; sb[j] = db; }
#pragma unroll
            for (int kk = 0; kk < 4; ++kk) { qff[kk] = scale_frag(qf[kk], sf); qfb[kk] = scale_frag(qf[kk], sb); }
        }
#pragma unroll
        for (int kk = 0; kk < 4; ++kk)
#pragma unroll
            for (int mb = 0; mb < 8; ++mb) {
                const bf16x8 af = *(const LAS bf16x8*)(RfT + (16 * mb + l15) * RS + (32 * kk + 8 * g) * 2);
                o[mb] = __builtin_amdgcn_mfma_f32_16x16x32_bf16(af, qff[kk], o[mb], 0, 0, 0);
                const bf16x8 ab = *(const LAS bf16x8*)(RbT + (16 * mb + l15) * RS + (32 * kk + 8 * g) * 2);
                o[mb] = __builtin_amdgcn_mfma_f32_16x16x32_bf16(ab, qfb[kk], o[mb], 0, 0, 0);
                if (mb == 3 || mb == 7) __builtin_amdgcn_sched_barrier(0);
            }
        float s1 = 0.f;
#pragma unroll
        for (int mb = 0; mb < 8; ++mb) s1 += o[mb][0] + o[mb][1] + o[mb][2] + o[mb][3];
        s1 += __shfl_xor(s1, 16, 64); s1 += __shfl_xor(s1, 32, 64);
        const float mu = s1 * (1.0f / 128.0f);
        float s2 = 0.f;
#pragma unroll
        for (int mb = 0; mb < 8; ++mb) { o[mb] -= mu; s2 += o[mb][0] * o[mb][0] + o[mb][1] * o[mb][1] + o[mb][2] * o[mb][2] + o[mb][3] * o[mb][3]; }
        s2 += __shfl_xor(s2, 16, 64); s2 += __shfl_xor(s2, 32, 64);
        const float rstd = rsqrtf(s2 * (1.0f / 128.0f) + EPS_F);
        bf16_t* dst = MIX + (size_t)(tok0 + c) * D + 512 + h * 128 + 4 * g;
#pragma unroll
        for (int mb = 0; mb < 8; ++mb) {
            const u32x2 sg = sgv[mb];
            u32x2 r;
            r[0] = cvt_pk_bf16(o[mb][0] * rstd * bf_lo(sg[0]), o[mb][1] * rstd * bf_hi(sg[0]));
            r[1] = cvt_pk_bf16(o[mb][2] * rstd * bf_lo(sg[1]), o[mb][3] * rstd * bf_hi(sg[1]));
            *(u32x2*)(dst + 16 * mb) = r;
        }
        __syncthreads();
    }
}

#define XB_TMO      128
#define XB_XCNT(j)  (256  + 64 * (j))
#define XB_XSUB(j)  (1280 + 64 * (j))
#define XB_XGEN(j)  (2304 + 64 * (j))
#define XB_TOP      3328
#define XB_TOPGEN   3392
#define XCD_BAR_WORDS 3456
#define XB_SPIN_CAP (1u << 18)

__device__ __forceinline__ unsigned xb_ld(unsigned* p)              { return __hip_atomic_load(p, __ATOMIC_RELAXED, __HIP_MEMORY_SCOPE_AGENT); }
__device__ __forceinline__ unsigned xb_add(unsigned* p, unsigned v) { return __hip_atomic_fetch_add(p, v, __ATOMIC_RELAXED, __HIP_MEMORY_SCOPE_AGENT); }
__device__ __forceinline__ unsigned xb_xcc_id() { return (unsigned)__builtin_amdgcn_s_getreg((3 << 11) | 20) & 0xFu; }
#define XB_SPIN(cond, bar) do { unsigned _sp = 0; while (cond) { __builtin_amdgcn_s_sleep(1); \
    if ((++_sp & 255u) == 0u) { if (xb_ld(&(bar)[XB_TMO])) break; if (_sp > XB_SPIN_CAP) { atomicAdd(&(bar)[XB_TMO], 1u); break; } } } } while (0)
struct XcdBarrier {
    unsigned* bar; unsigned x;
    volatile LAS unsigned* st;
};

__device__ __forceinline__ XcdBarrier xcd_barrier_post(unsigned* bar, volatile LAS unsigned* st) {
    XcdBarrier b; b.bar = bar; b.x = xb_xcc_id(); b.st = st;
    if (threadIdx.x == 0) (void)xb_add(&bar[XB_XCNT(b.x)], 1u);
    return b;
}
__device__ __forceinline__ void xcd_barrier_complete(unsigned* bar, unsigned x, unsigned& nloc, unsigned& nx) {
    const unsigned G = gridDim.x * gridDim.y * gridDim.z;
    unsigned sum, cnt, mine, sp = 0u;
    for (;;) {
        sum = 0u; cnt = 0u; mine = 0u;
#pragma unroll
        for (unsigned j = 0; j < 16; ++j) { const unsigned c = xb_ld(&bar[XB_XCNT(j)]); sum += c; cnt += (c > 0u) ? 1u : 0u; mine = (j == x) ? c : mine; }
        if (sum == G) break;
        __builtin_amdgcn_s_sleep(1);
        if ((++sp & 255u) == 0u) { if (xb_ld(&bar[XB_TMO])) break; if (sp > XB_SPIN_CAP) { atomicAdd(&bar[XB_TMO], 1u); break; } }
    }
    nloc = mine > 0u ? mine : 1u; nx = cnt > 0u ? cnt : 1u;
}

__device__ __forceinline__ void xcd_barrier(const XcdBarrier& b) {
    asm volatile("s_waitcnt vmcnt(0)" ::: "memory");
    __syncthreads();
    if (threadIdx.x == 0) {
        unsigned* bar = b.bar; asm volatile("" : "+s"(bar));
        __builtin_amdgcn_s_waitcnt(0);
        unsigned nloc = b.st[0], nx = b.st[1];
        if (nloc == 0u) { xcd_barrier_complete(bar, b.x, nloc, nx); b.st[0] = nloc; b.st[1] = nx; }
        const unsigned old = xb_add(&bar[XB_XSUB(b.x)], 1u);
        const unsigned gen = old / nloc;
        if (old + 1u == (gen + 1u) * nloc) {
            __builtin_amdgcn_fence(__ATOMIC_RELEASE, "agent");
            asm volatile("s_waitcnt vmcnt(0)" ::: "memory");
            const unsigned og = xb_add(&bar[XB_TOP], 1u);
            const unsigned tg = og / nx;
            if (og + 1u == (tg + 1u) * nx) xb_add(&bar[XB_TOPGEN], 1u);
            else XB_SPIN(xb_ld(&bar[XB_TOPGEN]) == tg, bar);
            __builtin_amdgcn_fence(__ATOMIC_ACQUIRE, "agent");
            xb_add(&bar[XB_XGEN(b.x)], 1u);
            asm volatile("s_waitcnt vmcnt(0)" ::: "memory");
        } else {
            XB_SPIN(xb_ld(&bar[XB_XGEN(b.x)]) == gen, bar);
            __builtin_amdgcn_fence(__ATOMIC_ACQUIRE, "agent");
            asm volatile("s_waitcnt vmcnt(0)" ::: "memory");
        }
    }
    __syncthreads();
}


constexpr int PPL = 8;
constexpr int N_PHASES = 2 + PPL * DEPTH;
#ifndef PHM
#define PHM 0xffff
#endif
__device__ __forceinline__ void run_phase(CP p, int ph, LAS unsigned char* lds, bool dry) {
    bf16_t* WT = (bf16_t*)(p->ws + WS_WT);
    bf16_t* H = (bf16_t*)(p->ws + WS_H); bf16_t* MIX = (bf16_t*)(p->ws + WS_MIX); bf16_t* ACT = (bf16_t*)(p->ws + WS_U);
    const float* MOD = (const float*)(p->ws + WS_MOD);
    if (ph == 0) { if (PHM & 1) phase_prep(p, lds); return; }
    if (ph == 1) { if (PHM & 2) phase_init(p); return; }
    const int l = (ph - 2) / PPL, s = (ph - 2) % PPL;
    if ((PHM & 4) && (s == 0 || s == 6)) {
        pg8::StaticOrder S;
        pg8::Gemm gm{H, WT + WT_W1 + (size_t)(s == 6) * 5632 * 1024, T, 2 * DFF, D};
        S.init(gm.M, gm.N, (int)gridDim.x, (int)blockIdx.x);
        EpiSwiglu E{ACT};
        pg8::gemm_phase<EpiSwiglu, pg8::StaticOrder>(lds, gm, S, E);
    } else if ((PHM & 8) && (s == 1 || s == 7 || s == 5)) {
        const int sub = s == 1 ? 0 : (s == 5 ? 1 : 2);
        const pg8::Gemm gm{s == 5 ? MIX : ACT, s == 5 ? WT + WT_WOUT : WT + WT_W2 + (size_t)(s == 7) * 1024 * 2816, T, D, s == 5 ? D : DFF};
        const EpiResLn E{p, l, sub, lds};
        QuadOrder S; S.init(gm.M, (int)blockIdx.x);
        pg8::gemm_phase<EpiResLn, QuadOrder>(lds, gm, S, E);
        if (s == 7 && l + 1 < DEPTH && (blockIdx.x >> 3) >= 16) convert_weights(p, l + 1, lds, (int)(blockIdx.x & 7) + 8 * ((int)(blockIdx.x >> 3) - 16), 128, 1);
        if (s == 1 && (blockIdx.x >> 3) >= 16) convert_weights(p, l, lds, (int)(blockIdx.x & 7) + 8 * ((int)(blockIdx.x >> 3) - 16), 128, l > 0 ? 2 : 4);
    } else if ((PHM & 16) && s == 2) {
        pg8::StaticOrder S;
        pg8::Gemm gm{H, WT + WT_WIN, T, DIN, D};
        S.init(gm.M, gm.N, (int)gridDim.x, (int)blockIdx.x);
        bf16_t* U = (bf16_t*)(p->ws + WS_U);
        EpiMixIn E{U, U + (size_t)T * 512, U + (size_t)2 * T * 512, U + (size_t)3 * T * 512, U + (size_t)4 * T * 512, U + (size_t)5 * T * 512, (const float*)(p->ws + WS_ROPE)};
        pg8::gemm_phase<EpiMixIn, pg8::StaticOrder>(lds, gm, S, E);
    }
    else if ((PHM & 32) && s == 3) { phase_mix2(p, l, lds); }
    else if ((PHM & 64) && s == 4) { phase_mix3(p, l, lds); }
}

#ifndef DUPM
#define DUPM 0
#endif
__global__ __launch_bounds__(512, 2) void mega_fwd(Params p) {
    extern __shared__ __attribute__((aligned(16))) unsigned char shm[];
    LAS unsigned char* lds = (LAS unsigned char*)shm;
    volatile LAS unsigned* st = (volatile LAS unsigned*)(lds + LDS_WORK);
    if (threadIdx.x < 4) st[threadIdx.x] = 0u;
    __syncthreads();
    const XcdBarrier xb = xcd_barrier_post((unsigned*)(p.ws + WS_BAR), st);
    for (int ph = p.ph_lo; ph < p.ph_hi; ++ph) {
        if (ph > p.ph_lo) {
            if (p.ph_hi < 0) cg::this_grid().sync();
            xcd_barrier(xb);
            if (DUPM & 64) xcd_barrier(xb);
        }
        int nrep = 1;
        if (DUPM) {
            const int s = ph >= 2 ? (ph - 2) % PPL : -1;
            if (((DUPM & 1) && s == 0) || ((DUPM & 2) && s == 2) || ((DUPM & 4) && s == 3) || ((DUPM & 8) && s == 4) || ((DUPM & 32) && ph == 0)) nrep = 2;
        }
        for (int rep = 0; rep < nrep; ++rep) {
            CP pp = (CP)__builtin_amdgcn_kernarg_segment_ptr();
            asm volatile("" : "+s"(pp));
            run_phase(pp, ph, lds, rep + 1 < nrep);
            if (rep + 1 < nrep) __syncthreads();
        }
    }
}

extern "C" void kernel_launch(void* const* d_in, const int* in_sizes, int n_in, void* d_out, int out_size, void* d_ws, size_t ws_size, hipStream_t stream) {
    static int grid = 0;
    if (grid == 0) {
        if (n_in != 19 || ws_size < WS_END) { fprintf(stderr, "kernel_launch: need 19 inputs and >= %zu bytes of workspace; got %d, %zu\n", (size_t)WS_END, n_in, ws_size); grid = -1; return; }
        int dev = 0, cus = 0, per_cu = 0;
        hipGetDevice(&dev);
        hipDeviceGetAttribute(&cus, hipDeviceAttributeMultiprocessorCount, dev);
        if (hipFuncSetAttribute((const void*)mega_fwd, hipFuncAttributeMaxDynamicSharedMemorySize, LDS_BYTES) != hipSuccess) { fprintf(stderr, "kernel_launch: hipFuncSetAttribute failed\n"); grid = -1; return; }
        if (hipOccupancyMaxActiveBlocksPerMultiprocessor(&per_cu, (const void*)mega_fwd, 512, LDS_BYTES) != hipSuccess || per_cu < 1) { fprintf(stderr, "kernel_launch: occupancy query says %d\n", per_cu); per_cu = 1; }
        (void)hipGetLastError();
        grid = cus * 1;
        if (grid != 256) { fprintf(stderr, "kernel_launch: built for 256 CUs, found %d\n", cus); grid = -1; return; }
    }
    if (grid < 0) return;
    (void)hipMemsetAsync((unsigned char*)d_ws + WS_BAR, 0, 3456 * 4, stream);
    Params p{};
    for (int i = 0; i < 19; ++i) p.in[i] = (const float*)d_in[i];
    p.out = (float*)d_out; p.ws = (unsigned char*)d_ws;
#if MK_PER_PHASE
    for (int ph = 0; ph < N_PHASES; ++ph) {
        p.ph_lo = ph; p.ph_hi = ph + 1;
        hipLaunchKernelGGL(mega_fwd, dim3(grid), dim3(512), LDS_BYTES, stream, p);
    }
#else
    p.ph_lo = 0; p.ph_hi = N_PHASES;
    void* args[] = {&p};
    hipError_t e = hipLaunchCooperativeKernel((const void*)mega_fwd, dim3(grid), dim3(512), args, LDS_BYTES, stream);
    if (e != hipSuccess) fprintf(stderr, "cooperative launch failed: %s (grid %d)\n", hipGetErrorString(e), grid);
#endif
}
```

```cpp
#include <hip/hip_runtime.h>
#include <hip/hip_cooperative_groups.h>
#include <cstdio>
namespace cg = cooperative_groups;

#ifndef MK_PER_PHASE
#define MK_PER_PHASE 0
#endif

namespace pg8 {
#define PG8_LAS __attribute__((address_space(3)))
typedef unsigned short bf16_t;
typedef short bf16x8 __attribute__((ext_vector_type(8)));
typedef float f32x4 __attribute__((ext_vector_type(4)));
typedef unsigned u32x4 __attribute__((ext_vector_type(4)));
constexpr int BM = 256, BK = 64, HALF = 128, HTB = HALF * BK * 2, STAGE_BYTES = 8 * HTB, NXCD = 8, WGM = 8;
__host__ __device__ __forceinline__ int lds_byte(int r, int c) { const int st = (r >> 4) * 2 + (c >> 5), rr = r & 15, cc = c & 31, ob = rr * 64 + cc * 2; return st * 1024 + (ob ^ (((ob >> 9) & 1) << 5)); }
__host__ __device__ __forceinline__ void stage_rc(int b, int& R, int& C) { const int st = b / 1024, sb = b % 1024, swz = sb ^ (((sb >> 9) & 1) << 5); R = (st >> 1) * 16 + swz / 64; C = (st & 1) * 32 + (swz % 64) / 2; }
__host__ __device__ __forceinline__ int perm32(int rho) { const int n = rho >> 4, i = rho & 15; return 8 * (i >> 2) + 4 * n + (i & 3); }
struct Unit { int pm, pn; };
struct Gemm { const bf16_t* A; const bf16_t* Bt; int M, N, K; };
struct StaticOrder {
    int nM, nN, nwg, G, c;
    __host__ __device__ void init(int M, int N, int G_, int c_) { nM = M / BM; nN = N / BM; nwg = nM * nN; G = G_; c = c_; }
    __host__ __device__ bool next(int i, Unit& u) const {
        const long L = (long)i * G + c; if (L >= nwg) return false;
        int wgid = (int)L; { const int q = nwg / NXCD, r = nwg % NXCD, xcd = wgid % NXCD, off = wgid / NXCD; wgid = (xcd < r ? xcd * (q + 1) : r * (q + 1) + (xcd - r) * q) + off; }
        const int nig = WGM * nN, gid = wgid / nig, fm = gid * WGM, gsz = (nM - fm) < WGM ? (nM - fm) : WGM;
        u.pm = fm + ((wgid % nig) % gsz); u.pn = (wgid % nig) / gsz; return true;
    }
    __device__ __forceinline__ void a_ready(const Unit&) const {}
    __device__ __forceinline__ void done(const Unit&) const {}
};
template <class Epi, class Sched>
__device__ __forceinline__ void gemm_phase(PG8_LAS unsigned char* lds, const Gemm g, const Sched& S, const Epi& E) {
    int tid_ = threadIdx.x; asm volatile("" : "+v"(tid_)); const int tid = tid_, wid = __builtin_amdgcn_readfirstlane(tid >> 6), lane = tid & 63, wr = wid >> 2, wc = wid & 3, fr = lane & 15, fq = lane >> 4;
    const int K = g.K, nt = K / BK;
    unsigned voffA[2], voffB[2];
#pragma unroll
    for (int i = 0; i < 2; ++i) { int R, C; stage_rc(tid * 16 + i * 8192, R, C); const int Rb = Epi::PERM ? ((R & ~31) + perm32(R & 31)) : R;
        voffA[i] = (unsigned)(R * K + C) * 2u; voffB[i] = (unsigned)(Rb * K + C) * 2u; }
    const size_t kstep = (size_t)(BK * 2);
    const size_t hstep = (size_t)HALF * K * 2;
    const size_t tstep = 2 * hstep;
    const unsigned ldsw = (unsigned)wid * 1024u;
    const int aoff = lds_byte(wr * 64 + fr, fq * 8), boff = lds_byte(wc * 32 + fr, fq * 8);
#define PG8_SA(b, h) (((b) * 2 + (h)) * HTB)
#define PG8_SB(b, h) ((4 + (b) * 2 + (h)) * HTB)
#define PG8_STAGE(bufoff, gbase, voff) do { _Pragma("unroll") for (int _i = 0; _i < 2; ++_i) \
        __builtin_amdgcn_global_load_lds((const unsigned*)((const char*)(gbase) + (voff)[_i]), (PG8_LAS unsigned*)(lds + (bufoff) + ldsw + _i * 8192), 16, 0, 0); } while (0)
#define PG8_LDA(dst, b, h) do { _Pragma("unroll") for (int m = 0; m < 4; ++m) _Pragma("unroll") for (int k = 0; k < 2; ++k) dst[m][k] = *(const PG8_LAS bf16x8*)(lds + PG8_SA(b, h) + aoff + m * 2048 + k * 1024); } while (0)
#define PG8_LDB(dst, b, h) do { _Pragma("unroll") for (int n = 0; n < 2; ++n) _Pragma("unroll") for (int k = 0; k < 2; ++k) dst[n][k] = *(const PG8_LAS bf16x8*)(lds + PG8_SB(b, h) + boff + n * 2048 + k * 1024); } while (0)
#define PG8_MMA(ai, bj, At, Bt) do { __builtin_amdgcn_s_setprio(1); _Pragma("unroll") for (int m = 0; m < 4; ++m) _Pragma("unroll") for (int n = 0; n < 2; ++n) _Pragma("unroll") for (int k = 0; k < 2; ++k) \
        acc[ai][bj][m][n] = __builtin_amdgcn_mfma_f32_16x16x32_bf16(Bt[n][k], At[m][k], acc[ai][bj][m][n], 0, 0, 0); __builtin_amdgcn_s_setprio(0); } while (0)
#define PG8_WAIT_V(n) asm volatile("s_waitcnt vmcnt(" #n ")" ::: "memory")
#define PG8_WAIT_L(n) asm volatile("s_waitcnt lgkmcnt(" #n ")" ::: "memory")
#define PG8_BAR __builtin_amdgcn_s_barrier()
#define PG8_SCHED __builtin_amdgcn_sched_barrier(0)
    Unit cur, nxt; int ui = 0;
    if (!S.next(0, cur)) return;
    f32x4 acc[2][2][4][2];
#pragma unroll
    for (int a = 0; a < 2; ++a)
#pragma unroll
        for (int b = 0; b < 2; ++b)
#pragma unroll
            for (int m = 0; m < 4; ++m)
#pragma unroll
                for (int n = 0; n < 2; ++n) acc[a][b][m][n] = (f32x4){0.f, 0.f, 0.f, 0.f};
    bf16x8 At[4][2], B0[2][2], B1[2][2];
    const char* cA = (const char*)g.A + (size_t)cur.pm * tstep; const char* cB = (const char*)g.Bt + (size_t)cur.pn * tstep;
    S.a_ready(cur);
    PG8_STAGE(PG8_SB(0, 0), cB, voffB); PG8_STAGE(PG8_SA(0, 0), cA, voffA); PG8_STAGE(PG8_SB(0, 1), cB + hstep, voffB); PG8_STAGE(PG8_SA(0, 1), cA + hstep, voffA);
    if (wr == 1) PG8_BAR;
    PG8_WAIT_V(4); PG8_BAR;
    PG8_STAGE(PG8_SB(1, 0), cB + kstep, voffB); PG8_STAGE(PG8_SA(1, 0), cA + kstep, voffA); PG8_STAGE(PG8_SB(1, 1), cB + hstep + kstep, voffB);
    PG8_WAIT_V(6); PG8_BAR;
    for (;;) {
        const bool has_next = S.next(ui + 1, nxt);
        const char* nA = has_next ? (const char*)g.A + (size_t)nxt.pm * tstep : cA; const char* nB = has_next ? (const char*)g.Bt + (size_t)nxt.pn * tstep : cB;
        for (int t = 0; t < nt; t += 2) {
            const bool last = (t == nt - 2);
            const char* a1 = cA + (size_t)(t + 1) * kstep;
            const char* a2 = last ? nA : cA + (size_t)(t + 2) * kstep; const char* b2 = last ? nB : cB + (size_t)(t + 2) * kstep;
            const char* a3 = a2 + kstep; const char* b3 = b2 + kstep;
            if (last && has_next) S.a_ready(nxt);
            PG8_LDB(B0, 0, 0); PG8_SCHED; PG8_LDA(At, 0, 0); PG8_STAGE(PG8_SA(1, 1), a1 + hstep, voffA);
            PG8_WAIT_L(8); PG8_BAR; PG8_WAIT_L(0); PG8_MMA(0, 0, At, B0); PG8_BAR; PG8_SCHED;
            PG8_LDB(B1, 0, 1); PG8_STAGE(PG8_SB(0, 0), b2, voffB);
            PG8_BAR; PG8_WAIT_L(0); PG8_MMA(0, 1, At, B1); PG8_BAR;
            PG8_LDA(At, 0, 1); PG8_STAGE(PG8_SA(0, 0), a2, voffA);
            PG8_BAR; PG8_WAIT_L(0); PG8_MMA(1, 0, At, B0); PG8_BAR; PG8_SCHED;
            PG8_STAGE(PG8_SB(0, 1), b2 + hstep, voffB);
            PG8_WAIT_V(6); PG8_BAR; PG8_MMA(1, 1, At, B1); PG8_BAR;
            PG8_LDB(B0, 1, 0); PG8_SCHED; PG8_LDA(At, 1, 0); PG8_STAGE(PG8_SA(0, 1), a2 + hstep, voffA);
            PG8_WAIT_L(8); PG8_BAR; PG8_WAIT_L(0); PG8_MMA(0, 0, At, B0); PG8_BAR; PG8_SCHED;
            PG8_LDB(B1, 1, 1); PG8_STAGE(PG8_SB(1, 0), b3, voffB);
            PG8_BAR; PG8_WAIT_L(0); PG8_MMA(0, 1, At, B1); PG8_BAR;
            PG8_LDA(At, 1, 1); PG8_STAGE(PG8_SA(1, 0), a3, voffA);
            PG8_BAR; PG8_WAIT_L(0); PG8_MMA(1, 0, At, B0); PG8_BAR; PG8_SCHED;
            PG8_STAGE(PG8_SB(1, 1), b3 + hstep, voffB);
            PG8_WAIT_V(6); PG8_BAR; PG8_MMA(1, 1, At, B1); PG8_BAR;
        }
        if constexpr (!Epi::AFTER_DRAIN) { E(acc, cur, wr, wc, fr, fq); S.done(cur); }
        if (!has_next) break;
#pragma unroll
        for (int a = 0; a < 2; ++a)
#pragma unroll
            for (int b = 0; b < 2; ++b)
#pragma unroll
                for (int m = 0; m < 4; ++m)
#pragma unroll
                    for (int n = 0; n < 2; ++n) acc[a][b][m][n] = (f32x4){0.f, 0.f, 0.f, 0.f};
        cur = nxt; cA = nA; cB = nB; ++ui;
    }
    PG8_WAIT_V(0);
    if (wr == 0) PG8_BAR;
    PG8_BAR;
    if constexpr (Epi::AFTER_DRAIN) { E.fused(acc, cur, wr, wc, fr, fq, lds, wid, lane); S.done(cur); }
#undef PG8_SA
#undef PG8_SB
#undef PG8_STAGE
#undef PG8_LDA
#undef PG8_LDB
#undef PG8_MMA
#undef PG8_WAIT_V
#undef PG8_WAIT_L
#undef PG8_BAR
#undef PG8_SCHED
}
}

#define LAS __attribute__((address_space(3)))
using pg8::bf16_t; using pg8::bf16x8; using pg8::f32x4;
typedef float f32x2 __attribute__((ext_vector_type(2)));
typedef unsigned u32x2 __attribute__((ext_vector_type(2)));
typedef unsigned u32x4v __attribute__((ext_vector_type(4)));

constexpr int D = 1024, DFF = 2816, DIN = 3072, DEPTH = 4;
constexpr int T_CTX = 8192, T_LAT = 32768, T = T_CTX + T_LAT;
constexpr int NCHUNK = T / 128;
constexpr int MODW = 9 * D;
constexpr float ALPHA_F = 1.6817928305074290f;
constexpr float EPS_F = 1e-5f;
constexpr int LDS_WORK = 139264;
constexpr int LDS_BYTES = LDS_WORK + 16;

constexpr size_t WS_X = 0;
constexpr size_t WS_H = WS_X + (size_t)T * D * 2;
constexpr size_t WS_MIX = WS_H + (size_t)T * D * 2;
constexpr size_t WS_U = WS_MIX + (size_t)T * D * 2;
constexpr size_t SZ_T512 = (size_t)T * 512 * 2;
constexpr size_t WS_RPT = WS_U + 6 * SZ_T512;
constexpr size_t WS_WT = WS_RPT + (size_t)2 * NCHUNK * 4 * 16384 * 2;
constexpr size_t WT_W1 = 0, WT_W2 = WT_W1 + (size_t)2 * 5632 * 1024, WT_WIN = WT_W2 + (size_t)2 * 1024 * 2816, WT_WOUT = WT_WIN + (size_t)3072 * 1024, WT_ELEMS = WT_WOUT + (size_t)1024 * 1024;
constexpr size_t WS_MOD = WS_WT + WT_ELEMS * 2;
constexpr size_t WS_ROPE = WS_MOD + (size_t)DEPTH * 9 * MODW * 4;
constexpr size_t WS_SLOT = WS_ROPE + 64 * 32 * 2 * 4;
constexpr size_t WS_CNT = WS_SLOT + (size_t)T * 16 * 8;
constexpr int CNT_PAD = 64;
constexpr int N_CNT = 12 * 160 * 2 * CNT_PAD;
constexpr size_t WS_BAR = WS_CNT + (size_t)N_CNT * 4;
constexpr size_t WS_END = WS_BAR + 3456 * 4;

constexpr size_t OUT_YS = 0, OUT_SF = (size_t)T * D, OUT_SB = OUT_SF + (size_t)32 * DEPTH * 4 * 16384;

struct Params {
    const float* in[19];
    float* out;
    unsigned char* ws;
    int ph_lo, ph_hi;
};
typedef const __attribute__((address_space(4))) Params* CP;
enum { I_XP = 0, I_XS, I_SF, I_SB, I_C, I_CCTX, I_WADA, I_BADA, I_LNG, I_LNB, I_W1, I_W2, I_WIN, I_WOUT, I_CW, I_CB, I_CLG, I_CLB, I_DEC };

__device__ __forceinline__ unsigned cvt_pk_bf16(float lo, float hi) { unsigned r; asm("v_cvt_pk_bf16_f32 %0, %1, %2" : "=v"(r) : "v"(lo), "v"(hi)); return r; }
__device__ __forceinline__ int my_tid() { int t = threadIdx.x; asm volatile("" : "+v"(t)); return t; }
__device__ __forceinline__ float bf_lo(unsigned u) { return __uint_as_float(u << 16); }
__device__ __forceinline__ float bf_hi(unsigned u) { return __uint_as_float(u & 0xffff0000u); }
__device__ __forceinline__ float fast_sigmoid(float x) { return __builtin_amdgcn_rcpf(1.0f + __expf(-x)); }
__device__ __forceinline__ float fast_silu(float x) { return x * fast_sigmoid(x); }
__device__ __forceinline__ int mod_row_of_tile(int pm) { return pm < 32 ? 0 : 1 + ((pm - 32) >> 4); }
__device__ __forceinline__ int mod_row_of_tok(int t) { return t < T_CTX ? 0 : 1 + ((t - T_CTX) >> 12); }
__device__ __forceinline__ float wave_sum(float v) {
#pragma unroll
    for (int o = 32; o >= 1; o >>= 1) v += __shfl_xor(v, o, 64);
    return v;
}
__device__ __forceinline__ float log_sigmoid_f(float x) { return -log1pf(__expf(-x)); }

struct EpiSwiglu {
    static constexpr bool PERM = true, AFTER_DRAIN = false;
    bf16_t* O;
    __device__ __forceinline__ void operator()(const f32x4 (&acc)[2][2][4][2], const pg8::Unit& u, int wr, int wc, int fr, int fq) const {
        const int row0 = u.pm * 256 + wr * 64 + fr, col0 = u.pn * 128 + wc * 32 + 8 * fq;
#pragma unroll
        for (int ai = 0; ai < 2; ++ai)
#pragma unroll
            for (int m = 0; m < 4; ++m) {
                bf16_t* dst = O + (size_t)(row0 + ai * 128 + m * 16) * DFF + col0;
                const f32x4 a0 = acc[ai][0][m][0], a1 = acc[ai][0][m][1], b0 = acc[ai][1][m][0], b1 = acc[ai][1][m][1];
                u32x4v o;
                o[0] = cvt_pk_bf16(fast_silu(a0[0]) * b0[0], fast_silu(a0[1]) * b0[1]);
                o[1] = cvt_pk_bf16(fast_silu(a0[2]) * b0[2], fast_silu(a0[3]) * b0[3]);
                o[2] = cvt_pk_bf16(fast_silu(a1[0]) * b1[0], fast_silu(a1[1]) * b1[1]);
                o[3] = cvt_pk_bf16(fast_silu(a1[2]) * b1[2], fast_silu(a1[3]) * b1[3]);
                *(u32x4v*)dst = o;
            }
    }
};
struct EpiResid {
    static constexpr bool PERM = false, AFTER_DRAIN = false;
    float* X; const float* gate; float gscale;
    __device__ __forceinline__ void operator()(const f32x4 (&acc)[2][2][4][2], const pg8::Unit& u, int wr, int wc, int fr, int fq) const {
        const int row0 = u.pm * 256 + wr * 64 + fr, col0 = u.pn * 256 + wc * 32 + 4 * fq;
        const float* gp = gate + (size_t)mod_row_of_tile(u.pm) * MODW + col0;
#pragma unroll
        for (int ai = 0; ai < 2; ++ai)
#pragma unroll
            for (int m = 0; m < 4; ++m) {
                float* rowp = X + (size_t)(row0 + ai * 128 + m * 16) * D + col0;
#pragma unroll
                for (int bj = 0; bj < 2; ++bj)
#pragma unroll
                    for (int n = 0; n < 2; ++n) {
                        const f32x4 gv = *(const f32x4*)(gp + bj * 128 + n * 16) * gscale;
                        f32x4 x = *(const f32x4*)(rowp + bj * 128 + n * 16);
                        x = x * ALPHA_F + gv * acc[ai][bj][m][n];
                        *(f32x4*)(rowp + bj * 128 + n * 16) = x;
                    }
            }
    }
};
struct QuadOrder {
    int nM, c;
    __device__ void init(int M, int c_) { nM = M / 256; c = c_; }
    __device__ bool next(int i, pg8::Unit& u) const {
        const int xcd = c & 7, k = c >> 3, full = nM >> 6;
        if (i < full) { u.pm = 64 * i + 8 * xcd + (k >> 2); u.pn = k & 3; return true; }
        if (i == full) { const int per = (nM - 64 * full) >> 3; if ((k >> 2) < per) { u.pm = 64 * full + per * xcd + (k >> 2); u.pn = k & 3; return true; } }
        return false;
    }
    __device__ __forceinline__ void a_ready(const pg8::Unit&) const {}
    __device__ __forceinline__ void done(const pg8::Unit&) const {}
};
typedef _Float16 f16x8 __attribute__((ext_vector_type(8)));
typedef float f32x8 __attribute__((ext_vector_type(8)));
struct EpiResLn {
    static constexpr bool PERM = true, AFTER_DRAIN = false;
    CP p; int l, sub; LAS unsigned char* ldsb;
    __device__ __forceinline__ void operator()(f32x4 (&acc)[2][2][4][2], const pg8::Unit& u, int wr, int wc, int fr, int fq) const {
        CP pp = p; asm volatile("" : "+s"(pp));
        f16x8* XP = (f16x8*)(pp->ws + WS_X); bf16_t* H = (bf16_t*)(pp->ws + WS_H);
        const bool fin = (l == DEPTH - 1 && sub == 2);
        float* OUT = pp->out;
        const float* MOD = (const float*)(pp->ws + WS_MOD);
        const float* gate = MOD + (size_t)l * 9 * MODW + (size_t)(sub == 1 ? 5 : (sub == 0 ? 2 : 8)) * D;
        const float gscale = sub == 1 ? 1.0f : 0.5f;
        const float* lng = pp->in[I_LNG] + (size_t)(l * 3 + sub) * D; const float* lnb = pp->in[I_LNB] + (size_t)(l * 3 + sub) * D;
        const int nl = sub == 2 ? (l + 1 < DEPTH ? l + 1 : l) : l, ns = sub == 2 ? 0 : sub + 1;
        const float* modn = MOD + (size_t)nl * 9 * MODW + (size_t)(3 * ns) * D;
        char* slots = (char*)(pp->ws + WS_SLOT); unsigned* cnt = (unsigned*)(pp->ws + WS_CNT) + (size_t)(l * 3 + sub) * 320 * CNT_PAD;
        const int lane = fr + 16 * fq;
        const int row0 = u.pm * 256 + wr * 64 + fr, col0 = u.pn * 256 + wc * 32 + 8 * fq;
        const unsigned xp0 = (unsigned)((((u.pm * 4 + u.pn) * 8 + wr * 4 + wc) * 16) * 64 + lane);
        const int mrow = mod_row_of_tile(u.pm);
        const float* gp = gate + (size_t)mrow * MODW + col0;
        float s1[8], s2[8];
#pragma unroll
        for (int i = 0; i < 8; ++i) { s1[i] = 0.f; s2[i] = 0.f; }
        f16x8 xq[16];
#pragma unroll
        for (int gq = 0; gq < 16; ++gq) xq[gq] = XP[xp0 + (unsigned)(gq * 64)];
        __builtin_amdgcn_sched_barrier(0);
#pragma unroll
        for (int bj = 0; bj < 2; ++bj) {
            const f32x4 gv0 = *(const f32x4*)(gp + bj * 128) * gscale, gv1 = *(const f32x4*)(gp + bj * 128 + 4) * gscale;
#pragma unroll
            for (int ai = 0; ai < 2; ++ai)
#pragma unroll
                for (int m = 0; m < 4; ++m) {
                    const f32x8 x = __builtin_convertvector(xq[(ai * 2 + bj) * 4 + m], f32x8);
                    const f32x4 z0 = (f32x4){x[0], x[1], x[2], x[3]} * ALPHA_F + gv0 * acc[ai][bj][m][0];
                    const f32x4 z1 = (f32x4){x[4], x[5], x[6], x[7]} * ALPHA_F + gv1 * acc[ai][bj][m][1];
                    acc[ai][bj][m][0] = z0; acc[ai][bj][m][1] = z1;
                    s1[ai * 4 + m] += ((z0[0] + z0[1]) + (z0[2] + z0[3])) + ((z1[0] + z1[1]) + (z1[2] + z1[3]));
                    s2[ai * 4 + m] += ((z0[0] * z0[0] + z0[1] * z0[1]) + (z0[2] * z0[2] + z0[3] * z0[3])) + ((z1[0] * z1[0] + z1[1] * z1[1]) + (z1[2] * z1[2] + z1[3] * z1[3]));
                }
        }
#pragma unroll
        for (int i = 0; i < 8; ++i) { s1[i] += __shfl_xor(s1[i], 16, 64); s2[i] += __shfl_xor(s2[i], 16, 64); }
#pragma unroll
        for (int i = 0; i < 8; ++i) { s1[i] += __shfl_xor(s1[i], 32, 64); s2[i] += __shfl_xor(s2[i], 32, 64); }
        const unsigned so0 = (unsigned)(row0 * 64);
#pragma unroll
        for (int i = 0; i < 8; ++i) {
            if ((i >> 1) == fq) {
                const unsigned v = (unsigned)__builtin_bit_cast(unsigned short, (_Float16)s1[i]) | ((unsigned)__builtin_bit_cast(unsigned short, (_Float16)s2[i]) << 16);
                __hip_atomic_store((unsigned*)(slots + (so0 + (unsigned)(((i >> 2) * 128 + (i & 3) * 16) * 64) + (unsigned)((u.pn * 4 + wc) * 4))), v, __ATOMIC_RELAXED, __HIP_MEMORY_SCOPE_AGENT);
            }
        }
        asm volatile("s_waitcnt vmcnt(0)" ::: "memory");
        const float* mp = modn + (size_t)mrow * MODW + col0;
        const f32x4 pg0 = *(const f32x4*)(lng + col0), pg1 = *(const f32x4*)(lng + col0 + 4), pb0 = *(const f32x4*)(lnb + col0), pb1 = *(const f32x4*)(lnb + col0 + 4);
        unsigned* cp = cnt + (u.pm * 2 + wr) * CNT_PAD;
        if (lane == 0) __hip_atomic_fetch_add(cp, 1u, __ATOMIC_RELAXED, __HIP_MEMORY_SCOPE_AGENT);
        const unsigned seq = (unsigned)((((l * 3 + sub) << 8) | u.pm) + 1);
        volatile LAS unsigned* fl = (volatile LAS unsigned*)(ldsb + LDS_WORK + 8 + 4 * wr);
        if (wc == 0) {
            for (int spins = 0; spins < (1 << 20); ++spins) {
                const unsigned v = __builtin_amdgcn_readfirstlane(__hip_atomic_load(cp, __ATOMIC_RELAXED, __HIP_MEMORY_SCOPE_AGENT));
                if (v >= 16u) break;
                __builtin_amdgcn_s_sleep(2);
            }
            if (lane == 0) *fl = seq;
        } else {
            for (int spins = 0; spins < (1 << 24); ++spins) {
                if ((unsigned)__builtin_amdgcn_readfirstlane((int)*fl) == seq) break;
                __builtin_amdgcn_s_sleep(1);
            }
        }
        unsigned xp1 = xp0, so1 = so0; asm volatile("" : "+v"(xp1), "+v"(so1));
        float mu[8], rs[8];
        const __amdgpu_buffer_rsrc_t srs = __builtin_amdgcn_make_buffer_rsrc((void*)slots, (short)0, (int)(T * 64), 0x00020000);
        {
            u32x4v sv[8];
#pragma unroll
            for (int i = 0; i < 8; ++i) sv[i] = __builtin_amdgcn_raw_buffer_load_b128(srs, so1 + (unsigned)(((i >> 2) * 128 + (i & 3) * 16) * 64) + (unsigned)(16 * fq), 0, 16);
            __builtin_amdgcn_sched_barrier(0);
            float sa[8], sb[8];
#pragma unroll
            for (int i = 0; i < 8; ++i) {
                float a = 0.f, b = 0.f;
#pragma unroll
                for (int q = 0; q < 4; ++q) { a += (float)__builtin_bit_cast(_Float16, (unsigned short)(sv[i][q] & 0xffffu)); b += (float)__builtin_bit_cast(_Float16, (unsigned short)(sv[i][q] >> 16)); }
                sa[i] = a; sb[i] = b;
            }
#pragma unroll
            for (int i = 0; i < 8; ++i) { sa[i] += __shfl_xor(sa[i], 16, 64); sb[i] += __shfl_xor(sb[i], 16, 64); }
#pragma unroll
            for (int i = 0; i < 8; ++i) { sa[i] += __shfl_xor(sa[i], 32, 64); sb[i] += __shfl_xor(sb[i], 32, 64); }
#pragma unroll
            for (int i = 0; i < 8; ++i) {
                const float m_ = sa[i] * (1.0f / D);
                mu[i] = m_; rs[i] = rsqrtf(fmaxf(sb[i] * (1.0f / D) - m_ * m_, 0.f) + EPS_F);
            }
        }
        const unsigned ro0 = (unsigned)(row0 * D + col0);
#pragma unroll
        for (int bj = 0; bj < 2; ++bj) {
            const int co = bj * 128;
            const f32x4 g0 = bj ? *(const f32x4*)(lng + col0 + co) : pg0, g1 = bj ? *(const f32x4*)(lng + col0 + co + 4) : pg1, b0 = bj ? *(const f32x4*)(lnb + col0 + co) : pb0, b1 = bj ? *(const f32x4*)(lnb + col0 + co + 4) : pb1;
            const f32x4 sh0 = *(const f32x4*)(mp + co), sh1 = *(const f32x4*)(mp + co + 4), sc0 = *(const f32x4*)(mp + D + co) + 1.0f, sc1 = *(const f32x4*)(mp + D + co + 4) + 1.0f;
#pragma unroll
            for (int ai = 0; ai < 2; ++ai)
#pragma unroll
                for (int m = 0; m < 4; ++m) {
                    const f32x4 x0 = (acc[ai][bj][m][0] - mu[ai * 4 + m]) * rs[ai * 4 + m] * g0 + b0, x1 = (acc[ai][bj][m][1] - mu[ai * 4 + m]) * rs[ai * 4 + m] * g1 + b1;
                    const unsigned ro = ro0 + (unsigned)((ai * 128 + m * 16) * D + co);
                    if (fin) { *(f32x4*)(OUT + ro) = x0; *(f32x4*)(OUT + ro + 4) = x1; }
                    else {
                        const f32x8 xv = (f32x8){x0[0], x0[1], x0[2], x0[3], x1[0], x1[1], x1[2], x1[3]};
                        XP[xp1 + (unsigned)(((ai * 2 + bj) * 4 + m) * 64)] = __builtin_convertvector(xv, f16x8);
                        const f32x4 h0 = x0 * sc0 + sh0, h1 = x1 * sc1 + sh1;
                        u32x4v o; o[0] = cvt_pk_bf16(h0[0], h0[1]); o[1] = cvt_pk_bf16(h0[2], h0[3]); o[2] = cvt_pk_bf16(h1[0], h1[1]); o[3] = cvt_pk_bf16(h1[2], h1[3]);
                        *(u32x4v*)(H + ro) = o;
                    }
                }
            __builtin_amdgcn_sched_barrier(0);
        }
    }
};
struct EpiMixIn {
    static constexpr bool PERM = true, AFTER_DRAIN = false;
    bf16_t *UPRE, *Q, *K, *KT, *VT, *SG; const float* rope;
    __device__ __forceinline__ void operator()(const f32x4 (&acc)[2][2][4][2], const pg8::Unit& u, int wr, int wc, int fr, int fq) const {
        const int row0 = u.pm * 256 + wr * 64 + fr;
        const int pn = u.pn;
        if (pn < 4) {
            const int col0 = pn * 128 + wc * 32 + 8 * fq;
#pragma unroll
            for (int ai = 0; ai < 2; ++ai)
#pragma unroll
                for (int m = 0; m < 4; ++m) {
                    const f32x4 a0 = acc[ai][0][m][0], a1 = acc[ai][0][m][1], b0 = acc[ai][1][m][0], b1 = acc[ai][1][m][1];
                    u32x4v o;
                    o[0] = cvt_pk_bf16(a0[0] * fast_sigmoid(b0[0]), a0[1] * fast_sigmoid(b0[1]));
                    o[1] = cvt_pk_bf16(a0[2] * fast_sigmoid(b0[2]), a0[3] * fast_sigmoid(b0[3]));
                    o[2] = cvt_pk_bf16(a1[0] * fast_sigmoid(b1[0]), a1[1] * fast_sigmoid(b1[1]));
                    o[3] = cvt_pk_bf16(a1[2] * fast_sigmoid(b1[2]), a1[3] * fast_sigmoid(b1[3]));
                    *(u32x4v*)(UPRE + (size_t)(row0 + ai * 128 + m * 16) * 512 + col0) = o;
                }
        } else if (pn < 8) {
            const bool isk = pn >= 6, lat = u.pm >= 32;
            const int head = 2 * (pn & 1) + (wc >> 1), colrot = wc & 1, dbase = 64 * colrot + 8 * fq;
            const float sc = isk ? 1.0f : 0.08838834764831845f;
            bf16_t* RM = isk ? K : Q;
#pragma unroll
            for (int ai = 0; ai < 2; ++ai)
#pragma unroll
                for (int m = 0; m < 4; ++m) {
                    const int row = row0 + ai * 128 + m * 16;
                    const int sp = (row - T_CTX) & 4095, pos = colrot ? (sp & 63) : (sp >> 6);
                    const float* rp = rope + (size_t)(pos * 32 + 8 * fq) * 2;
                    bf16_t* dst = RM + (size_t)row * 512 + head * 128 + dbase;
                    const int chunk = row >> 7, c = row & 127;
                    bf16_t* kt = KT + ((size_t)(chunk * 4 + head) * 128 + dbase) * 128 + c;
#pragma unroll
                    for (int n = 0; n < 2; ++n) {
                        const f32x4 x1 = acc[ai][0][m][n], x2 = acc[ai][1][m][n];
                        f32x4 o1, o2;
                        if (lat) {
                            const f32x4 csa = *(const f32x4*)(rp + 8 * n), csb = *(const f32x4*)(rp + 8 * n + 4);
                            o1[0] = x1[0] * csa[0] - x2[0] * csa[1]; o2[0] = x1[0] * csa[1] + x2[0] * csa[0];
                            o1[1] = x1[1] * csa[2] - x2[1] * csa[3]; o2[1] = x1[1] * csa[3] + x2[1] * csa[2];
                            o1[2] = x1[2] * csb[0] - x2[2] * csb[1]; o2[2] = x1[2] * csb[1] + x2[2] * csb[0];
                            o1[3] = x1[3] * csb[2] - x2[3] * csb[3]; o2[3] = x1[3] * csb[3] + x2[3] * csb[2];
                        } else { o1 = x1; o2 = x2; }
                        o1 *= sc; o2 *= sc;
                        u32x2 p1, p2;
                        p1[0] = cvt_pk_bf16(o1[0], o1[1]); p1[1] = cvt_pk_bf16(o1[2], o1[3]);
                        p2[0] = cvt_pk_bf16(o2[0], o2[1]); p2[1] = cvt_pk_bf16(o2[2], o2[3]);
                        *(u32x2*)(dst + 4 * n) = p1; *(u32x2*)(dst + 32 + 4 * n) = p2;
                        if (isk) {
#pragma unroll
                            for (int q = 0; q < 2; ++q) {
                                kt[(size_t)(4 * n + 2 * q) * 128] = (bf16_t)(p1[q] & 0xffffu); kt[(size_t)(4 * n + 2 * q + 1) * 128] = (bf16_t)(p1[q] >> 16);
                                kt[(size_t)(4 * n + 2 * q + 32) * 128] = (bf16_t)(p2[q] & 0xffffu); kt[(size_t)(4 * n + 2 * q + 33) * 128] = (bf16_t)(p2[q] >> 16);
                            }
                        }
                    }
                }
        } else if (pn < 10) {
#pragma unroll
            for (int ai = 0; ai < 2; ++ai)
#pragma unroll
                for (int m = 0; m < 4; ++m) {
                    const int row = row0 + ai * 128 + m * 16, chunk = row >> 7, c = row & 127;
#pragma unroll
                    for (int bj = 0; bj < 2; ++bj) {
                        const int head = 2 * (pn - 8) + bj, d0 = wc * 32 + 8 * fq;
                        bf16_t* vt = VT + ((size_t)(chunk * 4 + head) * 128 + d0) * 128 + c;
#pragma unroll
                        for (int n = 0; n < 2; ++n) {
                            const unsigned pa = cvt_pk_bf16(acc[ai][bj][m][n][0], acc[ai][bj][m][n][1]), pb = cvt_pk_bf16(acc[ai][bj][m][n][2], acc[ai][bj][m][n][3]);
                            vt[(size_t)(4 * n + 0) * 128] = (bf16_t)(pa & 0xffffu); vt[(size_t)(4 * n + 1) * 128] = (bf16_t)(pa >> 16);
                            vt[(size_t)(4 * n + 2) * 128] = (bf16_t)(pb & 0xffffu); vt[(size_t)(4 * n + 3) * 128] = (bf16_t)(pb >> 16);
                        }
                    }
                }
        } else {
            const int col0 = (pn - 10) * 256 + wc * 32 + 8 * fq;
#pragma unroll
            for (int ai = 0; ai < 2; ++ai)
#pragma unroll
                for (int m = 0; m < 4; ++m)
#pragma unroll
                    for (int bj = 0; bj < 2; ++bj) {
                        const f32x4 a0 = acc[ai][bj][m][0], a1 = acc[ai][bj][m][1];
                        u32x4v o;
                        o[0] = cvt_pk_bf16(fast_silu(a0[0]), fast_silu(a0[1])); o[1] = cvt_pk_bf16(fast_silu(a0[2]), fast_silu(a0[3]));
                        o[2] = cvt_pk_bf16(fast_silu(a1[0]), fast_silu(a1[1])); o[3] = cvt_pk_bf16(fast_silu(a1[2]), fast_silu(a1[3]));
                        *(u32x4v*)(SG + (size_t)(row0 + ai * 128 + m * 16) * 512 + col0 + bj * 128) = o;
                    }
        }
    }
};

__device__ __forceinline__ int wt_src_col(int mat, int np) {
    if (mat < 2) { const int t = np >> 8, bj = (np >> 7) & 1, j = np & 127; return bj * DFF + 128 * t + j; }
    if (mat == 4) {
        const int pn = np >> 8, bj = (np >> 7) & 1, j = np & 127;
        if (pn < 4) return bj * 512 + 128 * pn + j;
        if (pn < 8) { const int base = 1024 + 512 * ((pn - 4) >> 1), head = 2 * (pn & 1) + (j >> 6), e = j & 63; return base + head * 128 + (e < 32 ? e : e + 32) + 32 * bj; }
        return np;
    }
    return np;
}
__device__ void convert_weights(CP p, int layer, LAS unsigned char* lds, int start, int stride, int group, int jlo = 0, int jhi = 1 << 30) {
    const int tid = my_tid();
    bf16_t* WT = (bf16_t*)(p->ws + WS_WT);
    constexpr int LSTR = 264;
    const int ntile0 = group == 0 ? 2624 : (group == 1 ? 2272 : (group == 2 ? 352 : (group == 3 ? 1056 : 1568))), ntile = ntile0 < jhi ? ntile0 : jhi;
    const int kr = tid >> 3, n4 = (tid & 7) * 4;
    for (int j = jlo + start; j < ntile; j += 2 * stride) {
        f32x4 v[2][4]; bf16_t* drow[2]; int dKs[2]; bool ok[2];
#pragma unroll
        for (int u = 0; u < 2; ++u) {
            const int jj = j + u * stride; ok[u] = jj < ntile;
            const int jc = ok[u] ? jj : j;
            const int t = group == 0 ? jc : (group == 1 ? (jc < 1760 ? jc : jc + 352) : (group == 2 ? 1760 + jc : (group == 3 ? (jc < 704 ? jc : 1408 + (jc - 704)) : (jc < 704 ? 704 + jc : 1760 + (jc - 704)))));
            int mat, tl;
            if (t < 1408) { mat = t / 704; tl = t % 704; } else if (t < 2112) { mat = 2 + (t - 1408) / 352; tl = (t - 1408) % 352; } else if (t < 2496) { mat = 4; tl = t - 2112; } else { mat = 5; tl = t - 2496; }
            int Ks, Ns; const float* src; bf16_t* dst;
            if (mat < 2) { Ks = 1024; Ns = 5632; src = p->in[I_W1] + (size_t)(layer * 2 + mat) * 1024 * 5632; dst = WT + WT_W1 + (size_t)mat * 5632 * 1024; }
            else if (mat < 4) { Ks = 2816; Ns = 1024; src = p->in[I_W2] + (size_t)(layer * 2 + mat - 2) * 2816 * 1024; dst = WT + WT_W2 + (size_t)(mat - 2) * 1024 * 2816; }
            else if (mat == 4) { Ks = 1024; Ns = 3072; src = p->in[I_WIN] + (size_t)layer * 1024 * 3072; dst = WT + WT_WIN; }
            else { Ks = 1024; Ns = 1024; src = p->in[I_WOUT] + (size_t)layer * 1024 * 1024; dst = WT + WT_WOUT; }
            const int nkt = Ks >> 8, nt = tl / nkt, kt = tl % nkt;
            const int c0 = wt_src_col(mat, nt * 32);
            drow[u] = dst + (size_t)(nt * 32) * Ks + kt * 256; dKs[u] = Ks;
#pragma unroll
            for (int i = 0; i < 4; ++i) v[u][i] = *(const f32x4*)(src + (size_t)(kt * 256 + kr + 64 * i) * Ns + c0 + n4);
        }
#pragma unroll
        for (int u = 0; u < 2; ++u) {
            LAS bf16_t* L = (LAS bf16_t*)lds + u * (32 * LSTR);
#pragma unroll
            for (int i = 0; i < 4; ++i) {
                const unsigned a = cvt_pk_bf16(v[u][i][0], v[u][i][1]), b = cvt_pk_bf16(v[u][i][2], v[u][i][3]);
                const int k = kr + 64 * i;
                L[(n4 + 0) * LSTR + k] = (bf16_t)(a & 0xffffu); L[(n4 + 1) * LSTR + k] = (bf16_t)(a >> 16);
                L[(n4 + 2) * LSTR + k] = (bf16_t)(b & 0xffffu); L[(n4 + 3) * LSTR + k] = (bf16_t)(b >> 16);
            }
        }
        __syncthreads();
#pragma unroll
        for (int u = 0; u < 2; ++u) {
            if (ok[u]) {
                LAS bf16_t* L = (LAS bf16_t*)lds + u * (32 * LSTR);
                const int n = tid >> 4, kc = (tid & 15) * 16;
                const u32x4v r0 = *(const LAS u32x4v*)(L + n * LSTR + kc), r1 = *(const LAS u32x4v*)(L + n * LSTR + kc + 8);
                bf16_t* d = drow[u] + (size_t)n * dKs[u] + kc;
                *(u32x4v*)d = r0; *(u32x4v*)(d + 8) = r1;
            }
        }
        __syncthreads();
    }
}

__device__ void phase_prep(CP p, LAS unsigned char* lds) {
    const int tid = my_tid();
    float* MOD = (float*)(p->ws + WS_MOD);
    if (blockIdx.x == gridDim.x - 1) {
        float* rope = (float*)(p->ws + WS_ROPE);
        for (int e = tid; e < 2048; e += 512) {
            const int pos = e >> 5, f = e & 31;
            const float inv = exp2f(-(float)f * (13.287712379549449f / 32.0f));
            const float x = (float)pos * inv;
            const float r = x - 6.283185307179586f * rintf(x * 0.15915494309189535f);
            rope[2 * e] = cosf(r); rope[2 * e + 1] = sinf(r);
        }
    }
    if (blockIdx.x < 144) {
        LAS float* S = (LAS float*)lds;
        LAS float* R = (LAS float*)(lds + 9 * 1024 * 4);
        for (int i = tid; i < 9 * 1024; i += 512) {
            const int r = i >> 10, k = i & 1023;
            const float c = r == 0 ? p->in[I_CCTX][k] : p->in[I_C][(r - 1) * 1024 + k];
            S[i] = c / (1.0f + __expf(-c));
        }
        __syncthreads();
        for (int task = blockIdx.x; task < 144; task += gridDim.x) {
            const int l = task / 36, j0 = (task % 36) * 256;
            const int cq = tid & 63, ks = tid >> 6;
            const float* w = p->in[I_WADA] + ((size_t)l * 1024 + ks * 128) * MODW + j0 + 4 * cq;
            f32x4 acc[9];
#pragma unroll
            for (int r = 0; r < 9; ++r) acc[r] = (f32x4){0.f, 0.f, 0.f, 0.f};
#pragma unroll 4
            for (int k = 0; k < 128; ++k) {
                const f32x4 wv = *(const f32x4*)(w + (size_t)k * MODW);
#pragma unroll
                for (int r = 0; r < 9; ++r) acc[r] += wv * S[r * 1024 + ks * 128 + k];
            }
#pragma unroll
            for (int r = 0; r < 9; ++r) *(LAS f32x4*)(R + (ks * 9 + r) * 256 + 4 * cq) = acc[r];
            __syncthreads();
            for (int i = tid; i < 9 * 256; i += 512) {
                const int r = i >> 8, c = i & 255;
                float s = p->in[I_BADA][(size_t)l * MODW + j0 + c];
#pragma unroll
                for (int q = 0; q < 8; ++q) s += R[(q * 9 + r) * 256 + c];
                MOD[((size_t)l * 9 + r) * MODW + j0 + c] = s;
            }
            __syncthreads();
        }
    }
    {
        const bool nomod = blockIdx.x >= 144; const int split = 6 * 112;
        convert_weights(p, 0, lds, nomod ? (int)blockIdx.x - 144 : (int)blockIdx.x, nomod ? 112 : 144, 3, nomod ? 0 : split, nomod ? split : (1 << 30));
    }
    {
        unsigned* cnt = (unsigned*)(p->ws + WS_CNT);
        for (int i = blockIdx.x * 512 + tid; i < N_CNT; i += gridDim.x * 512) cnt[i] = 0u;
    }
}

__device__ void phase_init(CP p) {
    const int tid = my_tid();
    f16x8* XP = (f16x8*)(p->ws + WS_X); bf16_t* H = (bf16_t*)(p->ws + WS_H);
    const float* MOD = (const float*)(p->ws + WS_MOD);
    for (unsigned pc = blockIdx.x * 512 + tid; pc < (unsigned)(T / 256) * 4 * 8 * 16 * 64; pc += gridDim.x * 512) {
        const int lane = pc & 63, g = (pc >> 6) & 15, w = (pc >> 10) & 7, pn = (pc >> 13) & 3, pm = pc >> 15;
        const int fr = lane & 15, fq = lane >> 4, wr = w >> 2, wc = w & 3, ai = g >> 3, bj = (g >> 2) & 1, m = g & 3;
        const int row = pm * 256 + ai * 128 + wr * 64 + m * 16 + fr, col = pn * 256 + bj * 128 + wc * 32 + 8 * fq;
        const float* src = row < T_CTX ? p->in[I_XP] + (size_t)row * D + col : p->in[I_XS] + (size_t)(row - T_CTX) * D + col;
        const f32x4 x0 = *(const f32x4*)src, x1 = *(const f32x4*)(src + 4);
        const f32x8 xv = (f32x8){x0[0], x0[1], x0[2], x0[3], x1[0], x1[1], x1[2], x1[3]};
        XP[pc] = __builtin_convertvector(xv, f16x8);
        const float* mp = MOD + (size_t)mod_row_of_tok(row) * MODW + col;
        const f32x4 h0 = x0 * (*(const f32x4*)(mp + D) + 1.0f) + *(const f32x4*)mp, h1 = x1 * (*(const f32x4*)(mp + D + 4) + 1.0f) + *(const f32x4*)(mp + 4);
        u32x4v o; o[0] = cvt_pk_bf16(h0[0], h0[1]); o[1] = cvt_pk_bf16(h0[2], h0[3]); o[2] = cvt_pk_bf16(h1[0], h1[1]); o[3] = cvt_pk_bf16(h1[2], h1[3]);
        *(u32x4v*)(H + (size_t)row * D + col) = o;
    }
}

__device__ __forceinline__ bf16x8 scale_frag(bf16x8 f, const float (&s)[8]) {
    u32x4v u = __builtin_bit_cast(u32x4v, f), o;
#pragma unroll
    for (int q = 0; q < 4; ++q) o[q] = cvt_pk_bf16(bf_lo(u[q]) * s[2 * q], bf_hi(u[q]) * s[2 * q + 1]);
    return __builtin_bit_cast(bf16x8, o);
}
struct KvSet { bf16x8 a[4]; bf16x8 b[2][4]; };
__device__ void kv_scan_unit(CP p, int layer, int unit) {
    const int tid = my_tid(), w = tid >> 6, lane = tid & 63, l15 = lane & 15, g = lane >> 4;
    int s, h, dir, sl;
    if (unit < 256) { sl = unit & 3; dir = (unit >> 2) & 1; h = (unit >> 3) & 3; s = 32 + (unit >> 5); }
    else { const int u = unit - 256; sl = u & 3; dir = (u >> 2) & 1; h = (u >> 3) & 3; s = u >> 5; }
    const bool lat = s >= 32;
    const int nch = lat ? 32 : 2, chunk0 = lat ? 64 + 32 * (s - 32) : 2 * s;
    const bf16_t* KT = (const bf16_t*)(p->ws + WS_U + 3 * SZ_T512); const bf16_t* VT = (const bf16_t*)(p->ws + WS_U + 4 * SZ_T512);
    bf16_t* RPT = (bf16_t*)(p->ws + WS_RPT);
    const float lg = log_sigmoid_f(p->in[I_DEC][(layer * 2 + dir) * 4 + h]);
    const float cd = __expf(lg * 128.0f);
    float kj[8], kb[4];
#pragma unroll
    for (int j = 0; j < 8; ++j) kj[j] = __expf(lg * (float)(dir == 0 ? -j : j));
#pragma unroll
    for (int kk = 0; kk < 4; ++kk) kb[kk] = __expf(lg * (float)(dir == 0 ? 127 - 32 * kk - 8 * g : 32 * kk + 8 * g));
    const int dk0 = 16 * w + 4 * g;
    f32x4 acc[2];
#pragma unroll
    for (int nb = 0; nb < 2; ++nb) {
        if (lat) {
            const float* r0 = p->in[dir == 0 ? I_SF : I_SB] + ((size_t)((s - 32) * DEPTH + layer) * 4 + h) * 16384;
            const int dv = 32 * sl + 16 * nb + l15;
#pragma unroll
            for (int i = 0; i < 4; ++i) acc[nb][i] = r0[(size_t)(dk0 + i) * 128 + dv];
        } else acc[nb] = (f32x4){0.f, 0.f, 0.f, 0.f};
    }
    const bf16_t* kbase = KT + ((size_t)h * 128 + 16 * w + l15) * 128 + 8 * g;
    const bf16_t* vbase = VT + ((size_t)h * 128 + 32 * sl + l15) * 128 + 8 * g;
    auto chunk_of = [&](int i) { return chunk0 + (dir == 0 ? i : nch - 1 - i); };
    auto load_set = [&](KvSet& S, int i) {
        const size_t co = (size_t)chunk_of(i) * 4 * 16384;
#pragma unroll
        for (int kk = 0; kk < 4; ++kk) {
            S.a[kk] = *(const bf16x8*)(kbase + co + 32 * kk);
            S.b[0][kk] = *(const bf16x8*)(vbase + co + 32 * kk);
            S.b[1][kk] = *(const bf16x8*)(vbase + co + 16 * 128 + 32 * kk);
        }
    };
    auto step = [&](const KvSet& S, int i) {
        const int chunk = chunk_of(i);
#pragma unroll
        for (int nb = 0; nb < 2; ++nb) {
            const int dv = 32 * sl + 16 * nb + l15;
            u32x2 o; o[0] = cvt_pk_bf16(acc[nb][0], acc[nb][1]); o[1] = cvt_pk_bf16(acc[nb][2], acc[nb][3]);
            *(u32x2*)(RPT + (((size_t)(dir * NCHUNK + chunk) * 4 + h) * 128 + dv) * 128 + dk0) = o;
            acc[nb] *= cd;
        }
#pragma unroll
        for (int kk = 0; kk < 4; ++kk) {
            float sc[8];
#pragma unroll
            for (int j = 0; j < 8; ++j) sc[j] = kb[kk] * kj[j];
            const bf16x8 ak = scale_frag(S.a[kk], sc);
#pragma unroll
            for (int nb = 0; nb < 2; ++nb) acc[nb] = __builtin_amdgcn_mfma_f32_16x16x32_bf16(ak, S.b[nb][kk], acc[nb], 0, 0, 0);
        }
    };
    KvSet s0, s1, s2;
    load_set(s0, 0); load_set(s1, 1);
    for (int i = 0; i < nch; i += 3) {
        if (i + 2 < nch) load_set(s2, i + 2);
        step(s0, i);
        if (i + 1 < nch) { if (i + 3 < nch) load_set(s0, i + 3); step(s1, i + 1); }
        if (i + 2 < nch) { if (i + 4 < nch) load_set(s1, i + 4); step(s2, i + 2); }
    }
    if (!lat) {
        float* o = p->out + (dir == 0 ? OUT_SF : OUT_SB) + ((size_t)(s * DEPTH + layer) * 4 + h) * 16384;
#pragma unroll
        for (int nb = 0; nb < 2; ++nb) {
            const int dv = 32 * sl + 16 * nb + l15;
#pragma unroll
            for (int i = 0; i < 4; ++i) o[(size_t)(dk0 + i) * 128 + dv] = acc[nb][i];
        }
    }
}
__device__ void conv_units(CP p, int layer, LAS unsigned char* lds) {
    const int tid = my_tid(), lane = tid & 63, w = tid >> 6;
    const bf16_t* UPRE = (const bf16_t*)(p->ws + WS_U);
    bf16_t* MIX = (bf16_t*)(p->ws + WS_MIX);
    LAS unsigned char* lin = lds; LAS unsigned char* lout = lds + 62 * 1024;
    const int cp = tid & 255, th = tid >> 8;
    const float* cw = p->in[I_CW] + (size_t)layer * 31 * 512 + 2 * cp;
    f32x2 wgt[31];
#pragma unroll
    for (int j = 0; j < 31; ++j) wgt[j] = *(const f32x2*)(cw + (size_t)j * 512);
    const f32x2 bias = *(const f32x2*)(p->in[I_CB] + (size_t)layer * 512 + 2 * cp);
    const float* lg = p->in[I_CLG] + (size_t)layer * 512; const float* lb = p->in[I_CLB] + (size_t)layer * 512;
    const f32x4 g0 = *(const f32x4*)(lg + 4 * lane), g1 = *(const f32x4*)(lg + 256 + 4 * lane), b0 = *(const f32x4*)(lb + 4 * lane), b1 = *(const f32x4*)(lb + 256 + 4 * lane);
    u32x4v pre[8];
    auto issue = [&](int cu) {
        const int tok0 = cu * 32;
        int seg0, seg1;
        if (tok0 < T_CTX) { seg0 = tok0 & ~255; seg1 = seg0 + 256; } else { seg0 = tok0 & ~63; seg1 = seg0 + 64; }
#pragma unroll
        for (int k = 0; k < 8; ++k) {
            const int idx = tid + 512 * k, row = idx >> 6, ch = idx & 63, gr = tok0 - 15 + row;
            u32x4v v = (u32x4v){0u, 0u, 0u, 0u};
            if (idx < 62 * 64 && gr >= seg0 && gr < seg1) v = *(const u32x4v*)(UPRE + (size_t)gr * 512 + ch * 8);
            pre[k] = v;
        }
    };
    int cu = blockIdx.x;
    if (cu < 1280) issue(cu);
    for (; cu < 1280; cu += gridDim.x) {
        const int tok0 = cu * 32;
#pragma unroll
        for (int k = 0; k < 8; ++k) { const int idx = tid + 512 * k; if (idx < 62 * 64) *(LAS u32x4v*)(lin + (idx >> 6) * 1024 + (idx & 63) * 16) = pre[k]; }
        __syncthreads();
        if (cu + (int)gridDim.x < 1280) issue(cu + gridDim.x);
        f32x2 o[16];
#pragma unroll
        for (int t = 0; t < 16; ++t) o[t] = bias;
#pragma unroll
        for (int s = 0; s < 46; ++s) {
            const unsigned u = *(const LAS unsigned*)(lin + (16 * th + s) * 1024 + cp * 4);
            const f32x2 x = (f32x2){bf_lo(u), bf_hi(u)};
#pragma unroll
            for (int t = 0; t < 16; ++t) { if (s - t >= 0 && s - t <= 30) o[t] += wgt[s - t] * x; }
        }
#pragma unroll
        for (int t = 0; t < 16; ++t) *(LAS f32x2*)(lout + (16 * th + t) * 2048 + cp * 8) = o[t];
        __syncthreads();
#pragma unroll 2
        for (int tt = 0; tt < 4; ++tt) {
            const int t = 4 * w + tt;
            f32x4 v0 = *(const LAS f32x4*)(lout + t * 2048 + lane * 16), v1 = *(const LAS f32x4*)(lout + t * 2048 + 1024 + lane * 16);
            const float mu = wave_sum(v0[0] + v0[1] + v0[2] + v0[3] + v1[0] + v1[1] + v1[2] + v1[3]) * (1.0f / 512.0f);
            v0 -= mu; v1 -= mu;
            const float var = wave_sum(v0[0] * v0[0] + v0[1] * v0[1] + v0[2] * v0[2] + v0[3] * v0[3] + v1[0] * v1[0] + v1[1] * v1[1] + v1[2] * v1[2] + v1[3] * v1[3]) * (1.0f / 512.0f);
            const float rstd = rsqrtf(var + EPS_F);
            v0 = v0 * rstd * g0 + b0; v1 = v1 * rstd * g1 + b1;
            u32x2 q0, q1;
            q0[0] = cvt_pk_bf16(fast_silu(v0[0]), fast_silu(v0[1])); q0[1] = cvt_pk_bf16(fast_silu(v0[2]), fast_silu(v0[3]));
            q1[0] = cvt_pk_bf16(fast_silu(v1[0]), fast_silu(v1[1])); q1[1] = cvt_pk_bf16(fast_silu(v1[2]), fast_silu(v1[3]));
            bf16_t* dst = MIX + (size_t)(tok0 + t) * D;
            *(u32x2*)(dst + 4 * lane) = q0; *(u32x2*)(dst + 256 + 4 * lane) = q1;
        }
    }
    __syncthreads();
}
struct KvStep { int lat, s, h, dir, sl, i, nch, chunk; };
__device__ __forceinline__ KvStep kv_step(int j) {
    KvStep k; int u;
    if (j < 32) { u = blockIdx.x; k.lat = 1; k.i = j; k.nch = 32; k.s = 32 + (u >> 5); }
    else { u = blockIdx.x + 256 * ((j - 32) >> 1); k.lat = 0; k.i = (j - 32) & 1; k.nch = 2; k.s = u >> 5; }
    k.sl = u & 3; k.dir = (u >> 2) & 1; k.h = (u >> 3) & 3;
    const int chunk0 = k.lat ? 64 + 32 * (k.s - 32) : 2 * k.s;
    k.chunk = chunk0 + (k.dir == 0 ? k.i : k.nch - 1 - k.i);
    return k;
}
struct KvRegs { bf16x8 a[4]; u32x4v b; };
__device__ void kv_scan_stream(CP p, int layer, LAS unsigned char* lds) {
    const int tid = my_tid(), w = tid >> 6, lane = tid & 63, l15 = lane & 15, g = lane >> 4;
    const bf16_t* KT = (const bf16_t*)(p->ws + WS_U + 3 * SZ_T512); const bf16_t* VT = (const bf16_t*)(p->ws + WS_U + 4 * SZ_T512);
    bf16_t* RPT = (bf16_t*)(p->ws + WS_RPT);
    constexpr int NSTEP = 40, BRS = 272, BSLOT = 32 * BRS;
    const int dk0 = 16 * w + 4 * g;
    auto issue = [&](KvRegs& S, int j) {
        const KvStep k = kv_step(j);
        const bf16_t* kb = KT + ((size_t)(k.chunk * 4 + k.h) * 128 + 16 * w + l15) * 128 + 8 * g;
#pragma unroll
        for (int kk = 0; kk < 4; ++kk) S.a[kk] = *(const bf16x8*)(kb + 32 * kk);
        S.b = *(const u32x4v*)(VT + ((size_t)(k.chunk * 4 + k.h) * 128 + 32 * k.sl + (tid >> 4)) * 128 + (tid & 15) * 8);
    };
    f32x4 acc[2] = {(f32x4){0.f, 0.f, 0.f, 0.f}, (f32x4){0.f, 0.f, 0.f, 0.f}};
    float cd = 0.f, kj[8], kb4[4];
#pragma unroll
    for (int j = 0; j < 8; ++j) kj[j] = 0.f;
#pragma unroll
    for (int kk = 0; kk < 4; ++kk) kb4[kk] = 0.f;
    auto body = [&](KvRegs& S, int j) {
        const KvStep k = kv_step(j);
        LAS unsigned char* slot = lds + (j & 1) * BSLOT;
        *(LAS u32x4v*)(slot + (tid >> 4) * BRS + (tid & 15) * 16) = S.b;
        __syncthreads();
        if (k.i == 0) {
            const float lg = log_sigmoid_f(p->in[I_DEC][(layer * 2 + k.dir) * 4 + k.h]);
            cd = __expf(lg * 128.0f);
#pragma unroll
            for (int jj = 0; jj < 8; ++jj) kj[jj] = __expf(lg * (float)(k.dir == 0 ? -jj : jj));
#pragma unroll
            for (int kk = 0; kk < 4; ++kk) kb4[kk] = __expf(lg * (float)(k.dir == 0 ? 127 - 32 * kk - 8 * g : 32 * kk + 8 * g));
#pragma unroll
            for (int nb = 0; nb < 2; ++nb) {
                if (k.lat) {
                    const float* r0 = p->in[k.dir == 0 ? I_SF : I_SB] + ((size_t)((k.s - 32) * DEPTH + layer) * 4 + k.h) * 16384;
                    const int dv = 32 * k.sl + 16 * nb + l15;
#pragma unroll
                    for (int i = 0; i < 4; ++i) acc[nb][i] = r0[(size_t)(dk0 + i) * 128 + dv];
                } else acc[nb] = (f32x4){0.f, 0.f, 0.f, 0.f};
            }
        }
#pragma unroll
        for (int nb = 0; nb < 2; ++nb) {
            const int dv = 32 * k.sl + 16 * nb + l15;
            u32x2 o; o[0] = cvt_pk_bf16(acc[nb][0], acc[nb][1]); o[1] = cvt_pk_bf16(acc[nb][2], acc[nb][3]);
            *(u32x2*)(RPT + (((size_t)(k.dir * NCHUNK + k.chunk) * 4 + k.h) * 128 + dv) * 128 + dk0) = o;
            acc[nb] *= cd;
        }
#pragma unroll
        for (int kk = 0; kk < 4; ++kk) {
            float sc[8];
#pragma unroll
            for (int jj = 0; jj < 8; ++jj) sc[jj] = kb4[kk] * kj[jj];
            const bf16x8 ak = scale_frag(S.a[kk], sc);
#pragma unroll
            for (int nb = 0; nb < 2; ++nb) {
                const bf16x8 bfr = *(const LAS bf16x8*)(slot + (16 * nb + l15) * BRS + (32 * kk + 8 * g) * 2);
                acc[nb] = __builtin_amdgcn_mfma_f32_16x16x32_bf16(ak, bfr, acc[nb], 0, 0, 0);
            }
        }
        if (!k.lat && k.i == k.nch - 1) {
            float* o = p->out + (k.dir == 0 ? OUT_SF : OUT_SB) + ((size_t)(k.s * DEPTH + layer) * 4 + k.h) * 16384;
#pragma unroll
            for (int nb = 0; nb < 2; ++nb) {
                const int dv = 32 * k.sl + 16 * nb + l15;
#pragma unroll
                for (int i = 0; i < 4; ++i) o[(size_t)(dk0 + i) * 128 + dv] = acc[nb][i];
            }
        }
        if (j + 5 < NSTEP) issue(S, j + 5);
    };
    KvRegs s0, s1, s2, s3, s4;
    issue(s0, 0); issue(s1, 1); issue(s2, 2); issue(s3, 3); issue(s4, 4);
    for (int j = 0; j < NSTEP; j += 5) { body(s0, j); body(s1, j + 1); body(s2, j + 2); body(s3, j + 3); body(s4, j + 4); }
    __syncthreads();
}
__device__ void phase_mix2(CP p, int layer, LAS unsigned char* lds) {
    kv_scan_stream(p, layer, lds);
    conv_units(p, layer, lds);
}

__device__ void phase_mix3(CP p, int layer, LAS unsigned char* lds) {
    const int tid = my_tid(), w = tid >> 6, lane = tid & 63, l15 = lane & 15, g = lane >> 4;
    const bf16_t* Q = (const bf16_t*)(p->ws + WS_U + 1 * SZ_T512); const bf16_t* K = (const bf16_t*)(p->ws + WS_U + 2 * SZ_T512);
    const bf16_t* VT = (const bf16_t*)(p->ws + WS_U + 4 * SZ_T512); const bf16_t* SG = (const bf16_t*)(p->ws + WS_U + 5 * SZ_T512);
    const bf16_t* RPT = (const bf16_t*)(p->ws + WS_RPT);
    bf16_t* MIX = (bf16_t*)(p->ws + WS_MIX);
    constexpr int RS = 272, BUF = 128 * RS;
    LAS unsigned char* Ks = lds; LAS unsigned char* VTs = lds + BUF; LAS unsigned char* RfT = lds + 2 * BUF; LAS unsigned char* RbT = lds + 3 * BUF;
    u32x4v pre[16]; bf16x8 qpre[4];
    auto issue = [&](int pt) {
        const int chunk = pt >> 2, h = pt & 3, tok0 = chunk * 128;
#pragma unroll
        for (int i = 0; i < 4; ++i) {
            const int idx = tid + 512 * i, row = idx >> 4, ch = idx & 15;
            pre[4 * i + 0] = *(const u32x4v*)(K + (size_t)(tok0 + row) * 512 + h * 128 + ch * 8);
            pre[4 * i + 1] = *(const u32x4v*)(VT + ((size_t)(chunk * 4 + h) * 128 + row) * 128 + ch * 8);
            pre[4 * i + 2] = *(const u32x4v*)(RPT + (((size_t)chunk * 4 + h) * 128 + row) * 128 + ch * 8);
            pre[4 * i + 3] = *(const u32x4v*)(RPT + (((size_t)(NCHUNK + chunk) * 4 + h) * 128 + row) * 128 + ch * 8);
        }
#pragma unroll
        for (int kk = 0; kk < 4; ++kk) qpre[kk] = *(const bf16x8*)(Q + (size_t)(tok0 + 16 * w + l15) * 512 + h * 128 + 32 * kk + 8 * g);
    };
    if ((int)blockIdx.x < NCHUNK * 4) issue(blockIdx.x);
    for (int pt = blockIdx.x; pt < NCHUNK * 4; pt += gridDim.x) {
        const int chunk = pt >> 2, h = pt & 3, tok0 = chunk * 128;
#pragma unroll
        for (int i = 0; i < 4; ++i) {
            const int idx = tid + 512 * i, row = idx >> 4, ch = idx & 15;
            *(LAS u32x4v*)(Ks + row * RS + ch * 16) = pre[4 * i + 0]; *(LAS u32x4v*)(VTs + row * RS + ch * 16) = pre[4 * i + 1];
            *(LAS u32x4v*)(RfT + row * RS + ch * 16) = pre[4 * i + 2]; *(LAS u32x4v*)(RbT + row * RS + ch * 16) = pre[4 * i + 3];
        }
        int c = 16 * w + l15;
        asm volatile("" : "+v"(c));
        bf16x8 qf[4], qff[4], qfb[4];
        const float lgf = log_sigmoid_f(p->in[I_DEC][(layer * 2 + 0) * 4 + h]), lgb = log_sigmoid_f(p->in[I_DEC][(layer * 2 + 1) * 4 + h]);
        const float lf2 = lgf * 1.4426950408889634f, lb2 = lgb * 1.4426950408889634f;
#pragma unroll
        for (int kk = 0; kk < 4; ++kk) qf[kk] = qpre[kk];
        __syncthreads();
        if (pt + (int)gridDim.x < NCHUNK * 4) issue(pt + gridDim.x);
        u32x2 sgv[8];
        {
            const bf16_t* sgq = SG + (size_t)(tok0 + c) * 512 + h * 128 + 4 * g;
#pragma unroll
            for (int mb = 0; mb < 8; ++mb) sgv[mb] = *(const u32x2*)(sgq + 16 * mb);
        }
        u32x4v pf[4];
#pragma unroll
        for (int t = 0; t < 8; ++t) {
            f32x4 sacc = (f32x4){0.f, 0.f, 0.f, 0.f};
#pragma unroll
            for (int kk = 0; kk < 4; ++kk) {
                const bf16x8 a = *(const LAS bf16x8*)(Ks + (16 * t + l15) * RS + (32 * kk + 8 * g) * 2);
                sacc = __builtin_amdgcn_mfma_f32_16x16x32_bf16(a, qf[kk], sacc, 0, 0, 0);
            }
#pragma unroll
            for (int i = 0; i < 4; ++i) {
                const float dist = (float)(c - (16 * t + 4 * g + i));
                const float df = __builtin_amdgcn_exp2f(fmaf(lf2, dist, -1000.0f * fmaxf(-dist, 0.f))), db = __builtin_amdgcn_exp2f(fmaf(-lb2, dist, -1000.0f * fmaxf(dist, 0.f)));
                sacc[i] *= (df + db);
            }
            pf[t >> 1][2 * (t & 1)] = cvt_pk_bf16(sacc[0], sacc[1]); pf[t >> 1][2 * (t & 1) + 1] = cvt_pk_bf16(sacc[2], sacc[3]);
            if (t & 1) __builtin_amdgcn_sched_barrier(0);
        }
        f32x4 o[8];
#pragma unroll
        for (int mb = 0; mb < 8; ++mb) o[mb] = (f32x4){0.f, 0.f, 0.f, 0.f};
#pragma unroll
        for (int s = 0; s < 4; ++s) {
            const bf16x8 pb = __builtin_bit_cast(bf16x8, pf[s]);
#pragma unroll
            for (int mb = 0; mb < 8; ++mb) {
                const u32x2 lo = *(const LAS u32x2*)(VTs + (16 * mb + l15) * RS + (32 * s + 4 * g) * 2), hi = *(const LAS u32x2*)(VTs + (16 * mb + l15) * RS + (32 * s + 16 + 4 * g) * 2);
                const u32x4v av = (u32x4v){lo[0], lo[1], hi[0], hi[1]};
                o[mb] = __builtin_amdgcn_mfma_f32_16x16x32_bf16(__builtin_bit_cast(bf16x8, av), pb, o[mb], 0, 0, 0);
            }
            __builtin_amdgcn_sched_barrier(0);
        }
        __builtin_amdgcn_sched_barrier(0);
        {
            const float df = __expf(lgf * (float)(c + 1)), db = __expf(lgb * (float)(128 - c));
            float sf[8], sb[8];
#pragma unroll
            for (int j = 0; j < 8; ++j) { sf[j] = df; sb[j] = db; }
#pragma unroll
            for (int kk = 0; kk < 4; ++kk) { qff[kk] = scale_frag(qf[kk], sf); qfb[kk] = scale_frag(qf[kk], sb); }
        }
#pragma unroll
        for (int kk = 0; kk < 4; ++kk)
#pragma unroll
            for (int mb = 0; mb < 8; ++mb) {
                const bf16x8 af = *(const LAS bf16x8*)(RfT + (16 * mb + l15) * RS + (32 * kk + 8 * g) * 2);
                o[mb] = __builtin_amdgcn_mfma_f32_16x16x32_bf16(af, qff[kk], o[mb], 0, 0, 0);
                const bf16x8 ab = *(const LAS bf16x8*)(RbT + (16 * mb + l15) * RS + (32 * kk + 8 * g) * 2);
                o[mb] = __builtin_amdgcn_mfma_f32_16x16x32_bf16(ab, qfb[kk], o[mb], 0, 0, 0);
                if (mb == 3 || mb == 7) __builtin_amdgcn_sched_barrier(0);
            }
        float s1 = 0.f;
#pragma unroll
        for (int mb = 0; mb < 8; ++mb) s1 += o[mb][0] + o[mb][1] + o[mb][2] + o[mb][3];
        s1 += __shfl_xor(s1, 16, 64); s1 += __shfl_xor(s1, 32, 64);
        const float mu = s1 * (1.0f / 128.0f);
        float s2 = 0.f;
#pragma unroll
        for (int mb = 0; mb < 8; ++mb) { o[mb] -= mu; s2 += o[mb][0] * o[mb][0] + o[mb][1] * o[mb][1] + o[mb][2] * o[mb][2] + o[mb][3] * o[mb][3]; }
        s2 += __shfl_xor(s2, 16, 64); s2 += __shfl_xor(s2, 32, 64);
        const float rstd = rsqrtf(s2 * (1.0f / 128.0f) + EPS_F);
        bf16_t* dst = MIX + (size_t)(tok0 + c) * D + 512 + h * 128 + 4 * g;
#pragma unroll
        for (int mb = 0; mb < 8; ++mb) {
            const u32x2 sg = sgv[mb];
            u32x2 r;
            r[0] = cvt_pk_bf16(o[mb][0] * rstd * bf_lo(sg[0]), o[mb][1] * rstd * bf_hi(sg[0]));
            r[1] = cvt_pk_bf16(o[mb][2] * rstd * bf_lo(sg[1]), o[mb][3] * rstd * bf_hi(sg[1]));
            *(u32x2*)(dst + 16 * mb) = r;
        }
        __syncthreads();
    }
}

#define XB_TMO      128
#define XB_XCNT(j)  (256  + 64 * (j))
#define XB_XSUB(j)  (1280 + 64 * (j))
#define XB_XGEN(j)  (2304 + 64 * (j))
#define XB_TOP      3328
#define XB_TOPGEN   3392
#define XCD_BAR_WORDS 3456
#define XB_SPIN_CAP (1u << 18)

__device__ __forceinline__ unsigned xb_ld(unsigned* p)              { return __hip_atomic_load(p, __ATOMIC_RELAXED, __HIP_MEMORY_SCOPE_AGENT); }
__device__ __forceinline__ unsigned xb_add(unsigned* p, unsigned v) { return __hip_atomic_fetch_add(p, v, __ATOMIC_RELAXED, __HIP_MEMORY_SCOPE_AGENT); }
__device__ __forceinline__ unsigned xb_xcc_id() { return (unsigned)__builtin_amdgcn_s_getreg((3 << 11) | 20) & 0xFu; }
#define XB_SPIN(cond, bar) do { unsigned _sp = 0; while (cond) { __builtin_amdgcn_s_sleep(1); \
    if ((++_sp & 255u) == 0u) { if (xb_ld(&(bar)[XB_TMO])) break; if (_sp > XB_SPIN_CAP) { atomicAdd(&(bar)[XB_TMO], 1u); break; } } } } while (0)
struct XcdBarrier {
    unsigned* bar; unsigned x;
    volatile LAS unsigned* st;
};

__device__ __forceinline__ XcdBarrier xcd_barrier_post(unsigned* bar, volatile LAS unsigned* st) {
    XcdBarrier b; b.bar = bar; b.x = xb_xcc_id(); b.st = st;
    if (threadIdx.x == 0) (void)xb_add(&bar[XB_XCNT(b.x)], 1u);
    return b;
}
__device__ __forceinline__ void xcd_barrier_complete(unsigned* bar, unsigned x, unsigned& nloc, unsigned& nx) {
    const unsigned G = gridDim.x * gridDim.y * gridDim.z;
    unsigned sum, cnt, mine, sp = 0u;
    for (;;) {
        sum = 0u; cnt = 0u; mine = 0u;
#pragma unroll
        for (unsigned j = 0; j < 16; ++j) { const unsigned c = xb_ld(&bar[XB_XCNT(j)]); sum += c; cnt += (c > 0u) ? 1u : 0u; mine = (j == x) ? c : mine; }
        if (sum == G) break;
        __builtin_amdgcn_s_sleep(1);
        if ((++sp & 255u) == 0u) { if (xb_ld(&bar[XB_TMO])) break; if (sp > XB_SPIN_CAP) { atomicAdd(&bar[XB_TMO], 1u); break; } }
    }
    nloc = mine > 0u ? mine : 1u; nx = cnt > 0u ? cnt : 1u;
}

__device__ __forceinline__ void xcd_barrier(const XcdBarrier& b) {
    asm volatile("s_waitcnt vmcnt(0)" ::: "memory");
    __syncthreads();
    if (threadIdx.x == 0) {
        unsigned* bar = b.bar; asm volatile("" : "+s"(bar));
        __builtin_amdgcn_s_waitcnt(0);
        unsigned nloc = b.st[0], nx = b.st[1];
        if (nloc == 0u) { xcd_barrier_complete(bar, b.x, nloc, nx); b.st[0] = nloc; b.st[1] = nx; }
        const unsigned old = xb_add(&bar[XB_XSUB(b.x)], 1u);
        const unsigned gen = old / nloc;
        if (old + 1u == (gen + 1u) * nloc) {
            __builtin_amdgcn_fence(__ATOMIC_RELEASE, "agent");
            asm volatile("s_waitcnt vmcnt(0)" ::: "memory");
            const unsigned og = xb_add(&bar[XB_TOP], 1u);
            const unsigned tg = og / nx;
            if (og + 1u == (tg + 1u) * nx) xb_add(&bar[XB_TOPGEN], 1u);
            else XB_SPIN(xb_ld(&bar[XB_TOPGEN]) == tg, bar);
            __builtin_amdgcn_fence(__ATOMIC_ACQUIRE, "agent");
            xb_add(&bar[XB_XGEN(b.x)], 1u);
            asm volatile("s_waitcnt vmcnt(0)" ::: "memory");
        } else {
            XB_SPIN(xb_ld(&bar[XB_XGEN(b.x)]) == gen, bar);
            __builtin_amdgcn_fence(__ATOMIC_ACQUIRE, "agent");
            asm volatile("s_waitcnt vmcnt(0)" ::: "memory");
        }
    }
    __syncthreads();
}


constexpr int PPL = 8;
constexpr int N_PHASES = 2 + PPL * DEPTH;
#ifndef PHM
#define PHM 0xffff
#endif
__device__ __forceinline__ void run_phase(CP p, int ph, LAS unsigned char* lds, bool dry) {
    bf16_t* WT = (bf16_t*)(p->ws + WS_WT);
    bf16_t* H = (bf16_t*)(p->ws + WS_H); bf16_t* MIX = (bf16_t*)(p->ws + WS_MIX); bf16_t* ACT = (bf16_t*)(p->ws + WS_U);
    const float* MOD = (const float*)(p->ws + WS_MOD);
    if (ph == 0) { if (PHM & 1) phase_prep(p, lds); return; }
    if (ph == 1) { if (PHM & 2) phase_init(p); return; }
    const int l = (ph - 2) / PPL, s = (ph - 2) % PPL;
    if ((PHM & 4) && (s == 0 || s == 6)) {
        pg8::StaticOrder S;
        pg8::Gemm gm{H, WT + WT_W1 + (size_t)(s == 6) * 5632 * 1024, T, 2 * DFF, D};
        S.init(gm.M, gm.N, (int)gridDim.x, (int)blockIdx.x);
        EpiSwiglu E{ACT};
        pg8::gemm_phase<EpiSwiglu, pg8::StaticOrder>(lds, gm, S, E);
    } else if ((PHM & 8) && (s == 1 || s == 7 || s == 5)) {
        const int sub = s == 1 ? 0 : (s == 5 ? 1 : 2);
        const pg8::Gemm gm{s == 5 ? MIX : ACT, s == 5 ? WT + WT_WOUT : WT + WT_W2 + (size_t)(s == 7) * 1024 * 2816, T, D, s == 5 ? D : DFF};
        const EpiResLn E{p, l, sub, lds};
        QuadOrder S; S.init(gm.M, (int)blockIdx.x);
        pg8::gemm_phase<EpiResLn, QuadOrder>(lds, gm, S, E);
        if (s == 7 && l + 1 < DEPTH && (blockIdx.x >> 3) >= 16) convert_weights(p, l + 1, lds, (int)(blockIdx.x & 7) + 8 * ((int)(blockIdx.x >> 3) - 16), 128, 1);
        if (s == 1 && (blockIdx.x >> 3) >= 16) convert_weights(p, l, lds, (int)(blockIdx.x & 7) + 8 * ((int)(blockIdx.x >> 3) - 16), 128, l > 0 ? 2 : 4);
    } else if ((PHM & 16) && s == 2) {
        pg8::StaticOrder S;
        pg8::Gemm gm{H, WT + WT_WIN, T, DIN, D};
        S.init(gm.M, gm.N, (int)gridDim.x, (int)blockIdx.x);
        bf16_t* U = (bf16_t*)(p->ws + WS_U);
        EpiMixIn E{U, U + (size_t)T * 512, U + (size_t)2 * T * 512, U + (size_t)3 * T * 512, U + (size_t)4 * T * 512, U + (size_t)5 * T * 512, (const float*)(p->ws + WS_ROPE)};
        pg8::gemm_phase<EpiMixIn, pg8::StaticOrder>(lds, gm, S, E);
    }
    else if ((PHM & 32) && s == 3) { phase_mix2(p, l, lds); }
    else if ((PHM & 64) && s == 4) { phase_mix3(p, l, lds); }
}

#ifndef DUPM
#define DUPM 0
#endif
__global__ __launch_bounds__(512, 2) void mega_fwd(Params p) {
    extern __shared__ __attribute__((aligned(16))) unsigned char shm[];
    LAS unsigned char* lds = (LAS unsigned char*)shm;
    volatile LAS unsigned* st = (volatile LAS unsigned*)(lds + LDS_WORK);
    if (threadIdx.x < 4) st[threadIdx.x] = 0u;
    __syncthreads();
    const XcdBarrier xb = xcd_barrier_post((unsigned*)(p.ws + WS_BAR), st);
    for (int ph = p.ph_lo; ph < p.ph_hi; ++ph) {
        if (ph > p.ph_lo) {
            if (p.ph_hi < 0) cg::this_grid().sync();
            xcd_barrier(xb);
            if (DUPM & 64) xcd_barrier(xb);
        }
        int nrep = 1;
        if (DUPM) {
            const int s = ph >= 2 ? (ph - 2) % PPL : -1;
            if (((DUPM & 1) && s == 0) || ((DUPM & 2) && s == 2) || ((DUPM & 4) && s == 3) || ((DUPM & 8) && s == 4) || ((DUPM & 32) && ph == 0)) nrep = 2;
        }
        for (int rep = 0; rep < nrep; ++rep) {
            CP pp = (CP)__builtin_amdgcn_kernarg_segment_ptr();
            asm volatile("" : "+s"(pp));
            run_phase(pp, ph, lds, rep + 1 < nrep);
            if (rep + 1 < nrep) __syncthreads();
        }
    }
}

extern "C" void kernel_launch(void* const* d_in, const int* in_sizes, int n_in, void* d_out, int out_size, void* d_ws, size_t ws_size, hipStream_t stream) {
    static int grid = 0;
    if (grid == 0) {
        if (n_in != 19 || ws_size < WS_END) { fprintf(stderr, "kernel_launch: need 19 inputs and >= %zu bytes of workspace; got %d, %zu\n", (size_t)WS_END, n_in, ws_size); grid = -1; return; }
        int dev = 0, cus = 0, per_cu = 0;
        hipGetDevice(&dev);
        hipDeviceGetAttribute(&cus, hipDeviceAttributeMultiprocessorCount, dev);
        if (hipFuncSetAttribute((const void*)mega_fwd, hipFuncAttributeMaxDynamicSharedMemorySize, LDS_BYTES) != hipSuccess) { fprintf(stderr, "kernel_launch: hipFuncSetAttribute failed\n"); grid = -1; return; }
        if (hipOccupancyMaxActiveBlocksPerMultiprocessor(&per_cu, (const void*)mega_fwd, 512, LDS_BYTES) != hipSuccess || per_cu < 1) { fprintf(stderr, "kernel_launch: occupancy query says %d\n", per_cu); per_cu = 1; }
        (void)hipGetLastError();
        grid = cus * 1;
        if (grid != 256) { fprintf(stderr, "kernel_launch: built for 256 CUs, found %d\n", cus); grid = -1; return; }
    }
    if (grid < 0) return;
    (void)hipMemsetAsync((unsigned char*)d_ws + WS_BAR, 0, 3456 * 4, stream);
    Params p{};
    for (int i = 0; i < 19; ++i) p.in[i] = (const float*)d_in[i];
    p.out = (float*)d_out; p.ws = (unsigned char*)d_ws;
#if MK_PER_PHASE
    for (int ph = 0; ph < N_PHASES; ++ph) {
        p.ph_lo = ph; p.ph_hi = ph + 1;
        hipLaunchKernelGGL(mega_fwd, dim3(grid), dim3(512), LDS_BYTES, stream, p);
    }
#else
    p.ph_lo = 0; p.ph_hi = N_PHASES;
    void* args[] = {&p};
    hipError_t e = hipLaunchCooperativeKernel((const void*)mega_fwd, dim3(grid), dim3(512), args, LDS_BYTES, stream);
    if (e != hipSuccess) fprintf(stderr, "cooperative launch failed: %s (grid %d)\n", hipGetErrorString(e), grid);
#endif
}
```
